# Optimizing an MI355X kernel written in HIP

```python
import math
import jax
import jax.numpy as jnp
from jax import lax
import numpy as np

D_MODEL = 2048
BATCH = 4
SEQ = 8192
DEPTH = 4
DEC_BATCH = 2
DEC_SEQ = 4096
PAST_LEN = 128

GRID_W = 64
N_MEM = 256
HY_WIDTH = 3 * D_MODEL // 4
S5_WIDTH = D_MODEL - HY_WIDTH
S5_GROUP = 16
S5_GROUPS = S5_WIDTH // S5_GROUP
S5_STATE = 64
S5_DT_MIN = 1e-3
S5_DT_MAX = 1e-1
HY_ORDER = 2
HY_BANDS = 16
HY_EMB = 2 * HY_BANDS + 1
HY_FILTER_HIDDEN = 64
HY_DECAY_TARGET = 1e-2
HY_SHORT_DECAY_PCT = 0.3
HY_LONG_DECAY_PCT = 1.5
RET_WIDTH = D_MODEL // 2
RET_HEADS = 4
RET_HEAD_DIM = RET_WIDTH // RET_HEADS
RET_CHUNK = 128
ROPE_BASE = 10000.0
NA_WIDTH = D_MODEL - RET_WIDTH
NA_HEADS = 16
NA_HEAD_DIM = NA_WIDTH // NA_HEADS
NA_WIN_ROWS = 8
NA_WIN_COLS = 16
XA_HEADS = 4
XA_HEAD_DIM = D_MODEL // XA_HEADS
FFN_HIDDEN = ((8 * D_MODEL + 3 * 256 - 1) // (3 * 256)) * 256
N_EVEN = (DEPTH + 1) // 2
N_ODD = DEPTH // 2
RMS_EPS = 1e-6
GN_EPS = 1e-6

kernel_name = 'hybrid_bidir_hyena_s5_retnet_natten_encoder'


def _rms_norm(x, g):
    xf = x.astype(jnp.float32)
    y = xf * lax.rsqrt(jnp.mean(xf * xf, axis=-1, keepdims=True) + RMS_EPS)
    return (y * g.astype(jnp.float32)).astype(x.dtype)


def _short_conv(u, w, b):
    up = jnp.pad(u, ((0, 0), (1, 1), (0, 0)))
    return up[:, :-2] * w[0] + up[:, 1:-1] * w[1] + up[:, 2:] * w[2] + b


def _hyena_filter_spectra(L, w1, b1, freq, w2, b2, w3):
    f32 = jnp.float32
    t = jnp.arange(L, dtype=f32) / L
    bands = jnp.arange(1, HY_BANDS + 1, dtype=f32)
    ang = 2.0 * math.pi * t[:, None] * bands[None, :]
    feats = jnp.concatenate([t[:, None], jnp.cos(ang), jnp.sin(ang)], axis=-1)
    h = jnp.sin(freq[0].astype(f32) * (feats @ w1.astype(f32) + b1.astype(f32)))
    h = jnp.sin(freq[1].astype(f32) * (h @ w2.astype(f32) + b2.astype(f32)))
    h = (h @ w3.astype(f32)).reshape(L, HY_ORDER, 2, HY_WIDTH)
    deltas = jnp.abs(jnp.linspace(math.log(HY_DECAY_TARGET) / HY_LONG_DECAY_PCT,
                                  math.log(HY_DECAY_TARGET) / HY_SHORT_DECAY_PCT, HY_WIDTH, dtype=f32))
    h = h * jnp.exp(-t[:, None] * deltas[None, :])[:, None, None, :]
    h_fwd, h_bwd = h[:, :, 0], h[:, :, 1]
    h_two = jnp.concatenate([h_fwd, jnp.zeros((1, HY_ORDER, HY_WIDTH), f32), h_bwd[:0:-1]], axis=0)
    return jnp.fft.rfft(h_two, axis=0)


def _fft_long_conv(z, spec):
    L = z.shape[1]
    zf = jnp.fft.rfft(z, n=2 * L, axis=1)
    return jnp.fft.irfft(zf * spec[None], n=2 * L, axis=1)[:, :L]


def _hyena(u, short_w, short_b, w1, b1, freq, w2, b2, w3, skip, out_g):
    L = u.shape[1]
    u = _short_conv(u, short_w.astype(jnp.float32), short_b.astype(jnp.float32))
    v, x1, x2 = jnp.split(u, 3, axis=-1)
    spec = _hyena_filter_spectra(L, w1, b1, freq, w2, b2, w3)
    skip = skip.astype(jnp.float32)
    z = x1 * (_fft_long_conv(v, spec[:, 0]) + skip[0] * v)
    z = x2 * (_fft_long_conv(z, spec[:, 1]) + skip[1] * z)
    return _rms_norm(z, out_g)


def _lin_combine(e1, e2):
    a1, b1 = e1
    a2, b2 = e2
    return a1 * a2, a2 * b1 + b2


def _s5_one_way(u, lam_bar, b_bar, c):
    bu = jnp.einsum('blgi,gpi->blgp', u.astype(jnp.complex64), b_bar)
    a = jnp.broadcast_to(lam_bar, bu.shape)
    _, s = lax.associative_scan(_lin_combine, (a, bu), axis=1)
    return jnp.einsum('blgp,gip->blgi', s, c).real


def _s5(u, a_re, a_im, log_dt, b_re, b_im, c_re, c_im, d, w_glu):
    f32 = jnp.float32
    b, L, _ = u.shape
    ug = u.reshape(b, L, S5_GROUPS, S5_GROUP)
    lam = lax.complex(a_re.astype(f32), a_im.astype(f32))
    step = jnp.exp(log_dt.astype(f32))[..., None]
    lam_bar = jnp.exp(lam * step)
    b_bar = ((lam_bar - 1.0) / lam)[..., None] * lax.complex(b_re.astype(f32), b_im.astype(f32))
    c = lax.complex(c_re.astype(f32), c_im.astype(f32))
    y = _s5_one_way(ug, lam_bar[0], b_bar[0], c[0]) + jnp.flip(
        _s5_one_way(jnp.flip(ug, 1), lam_bar[1], b_bar[1], c[1]), 1)
    y = y.reshape(b, L, S5_WIDTH) + d.astype(f32) * u
    y = jax.nn.gelu(y)
    return y * jax.nn.sigmoid(y @ w_glu.astype(f32))


def _even_mixer(h, w_in, short_w, short_b, w1, b1, freq, w2, b2, w3, skip, out_g,
                a_re, a_im, log_dt, b_re, b_im, c_re, c_im, d, w_glu):
    p = (h @ w_in).astype(jnp.float32)
    hy = _hyena(p[..., :3 * HY_WIDTH], short_w, short_b, w1, b1, freq, w2, b2, w3, skip, out_g)
    ss = _s5(p[..., 3 * HY_WIDTH:], a_re, a_im, log_dt, b_re, b_im, c_re, c_im, d, w_glu)
    return jnp.concatenate([hy, ss], axis=-1).astype(h.dtype)


def _rotary(x):
    L, dim = x.shape[1], x.shape[-1]
    inv = ROPE_BASE ** (-jnp.arange(0, dim, 2, dtype=jnp.float32) / dim)
    ang = jnp.arange(L, dtype=jnp.float32)[:, None] * inv[None, :]
    cos = jnp.cos(ang)[None, :, None, :]
    sin = jnp.sin(ang)[None, :, None, :]
    x1, x2 = x[..., :dim // 2], x[..., dim // 2:]
    return jnp.concatenate([x1 * cos - x2 * sin, x1 * sin + x2 * cos], axis=-1)


def _retention_one_way(q, k, v, log_gamma, strict):
    b, L, H, dk = q.shape
    dv = v.shape[-1]
    nc = L // RET_CHUNK
    qc = q.reshape(b, nc, RET_CHUNK, H, dk)
    kc = k.reshape(b, nc, RET_CHUNK, H, dk)
    vc = v.reshape(b, nc, RET_CHUNK, H, dv)
    pos = jnp.arange(RET_CHUNK, dtype=jnp.float32)
    rel = pos[:, None] - pos[None, :]
    mask = rel > 0 if strict else rel >= 0
    decay = jnp.where(mask[None], jnp.exp(jnp.where(mask, rel, 0.0)[None] * log_gamma[:, None, None]), 0.0)
    s = jnp.einsum('bnihd,bnjhd->bnhij', qc, kc) * decay
    intra = jnp.einsum('bnhij,bnjhe->bnihe', s, vc)
    q_scale = jnp.exp((pos + 1.0)[:, None] * log_gamma[None, :])
    k_scale = jnp.exp((RET_CHUNK - 1.0 - pos)[:, None] * log_gamma[None, :])
    chunk_decay = jnp.exp(RET_CHUNK * log_gamma)

    def step(state, xs):
        q_c, k_c, v_c = xs
        inter = jnp.einsum('bihd,bhde->bihe', q_c * q_scale[None, :, :, None], state)
        state = chunk_decay[None, :, None, None] * state + jnp.einsum(
            'bjhd,bjhe->bhde', k_c * k_scale[None, :, :, None], v_c)
        return state, inter

    s0 = jnp.zeros((b, H, dk, dv), jnp.float32)
    _, inter = lax.scan(step, s0, (jnp.moveaxis(qc, 1, 0), jnp.moveaxis(kc, 1, 0), jnp.moveaxis(vc, 1, 0)))
    return (intra + jnp.moveaxis(inter, 0, 1)).reshape(b, L, H, dv)


def _retention(q, k, v, g, ret_decay):
    b, L, _ = q.shape
    shp = (b, L, RET_HEADS, RET_HEAD_DIM)
    q = _rotary(q.reshape(shp))
    k = _rotary(k.reshape(shp)) * RET_HEAD_DIM ** -0.5
    v = v.reshape(shp)
    log_gamma = -jnp.exp(ret_decay.astype(jnp.float32))
    o = _retention_one_way(q, k, v, log_gamma[0], False) + jnp.flip(
        _retention_one_way(jnp.flip(q, 1), jnp.flip(k, 1), jnp.flip(v, 1), log_gamma[1], True), 1)
    mu = jnp.mean(o, axis=-1, keepdims=True)
    var = jnp.var(o, axis=-1, keepdims=True)
    o = (o - mu) * lax.rsqrt(var + GN_EPS)
    return o.reshape(b, L, RET_WIDTH) * jax.nn.silu(g)


def _neighborhood_attention(q, k, v, rpb):
    b, L, _ = q.shape
    rows = L // GRID_W
    wr = min(NA_WIN_ROWS, rows)
    shp = (b, rows, GRID_W, NA_HEADS, NA_HEAD_DIM)
    qg, kg, vg = q.reshape(shp), k.reshape(shp), v.reshape(shp)
    cols = np.arange(GRID_W)
    col_start = np.clip(cols - NA_WIN_COLS // 2, 0, GRID_W - NA_WIN_COLS)
    col_idx = col_start[:, None] + np.arange(NA_WIN_COLS)[None, :]
    col_off = col_idx - cols[:, None] + (NA_WIN_COLS - 1)
    rpb_c = jnp.transpose(rpb.astype(jnp.float32)[:, :, col_off], (0, 2, 1, 3))
    scale = NA_HEAD_DIM ** -0.5

    def row_fn(r):
        rs = jnp.clip(r - wr // 2, 0, rows - wr)
        q_r = lax.dynamic_index_in_dim(qg, r, axis=1, keepdims=False)
        k_win = lax.dynamic_slice_in_dim(kg, rs, wr, axis=1)[:, :, col_idx]
        v_win = lax.dynamic_slice_in_dim(vg, rs, wr, axis=1)[:, :, col_idx]
        row_off = rs + jnp.arange(wr) - r + (NA_WIN_ROWS - 1)
        bias = jnp.take(rpb_c, row_off, axis=2)
        s = jnp.einsum('bchd,brcwhd->bhcrw', q_r, k_win) * scale + bias[None]
        p = jax.nn.softmax(s.reshape(b, NA_HEADS, GRID_W, wr * NA_WIN_COLS), axis=-1).reshape(s.shape)
        return jnp.einsum('bhcrw,brcwhd->bchd', p, v_win)

    out = lax.map(row_fn, jnp.arange(rows))
    return jnp.moveaxis(out, 0, 1).reshape(b, L, NA_WIDTH)


def _odd_mixer(h, w_in, ret_decay, na_rpb):
    p = (h @ w_in).astype(jnp.float32)
    rw, nw = RET_WIDTH, NA_WIDTH
    q_r, k_r, v_r, g_r, q_n, k_n, v_n = jnp.split(
        p, [rw, 2 * rw, 3 * rw, 4 * rw, 4 * rw + nw, 4 * rw + 2 * nw], axis=-1)
    ret = _retention(q_r, k_r, v_r, g_r, ret_decay)
    na = _neighborhood_attention(q_n, k_n, v_n, na_rpb)
    return jnp.concatenate([ret, na], axis=-1).astype(h.dtype)


def _memory_cross_attention(h, mem, mem_g, wq, wkv, wo):
    b, L, _ = h.shape
    m_len = mem.shape[1]
    m = _rms_norm(mem, mem_g)
    q = (h @ wq).reshape(b, L, XA_HEADS, XA_HEAD_DIM)
    k, v = jnp.split(m @ wkv, 2, axis=-1)
    k = k.reshape(b, m_len, XA_HEADS, XA_HEAD_DIM)
    v = v.reshape(b, m_len, XA_HEADS, XA_HEAD_DIM)
    s = jnp.einsum('blhd,bmhd->bhlm', q, k).astype(jnp.float32) * XA_HEAD_DIM ** -0.5
    p = jax.nn.softmax(s, axis=-1).astype(h.dtype)
    o = jnp.einsum('bhlm,bmhd->blhd', p, v).reshape(b, L, D_MODEL)
    return o @ wo


def _swiglu(h, wg, wu, wd):
    return (jax.nn.silu(h @ wg) * (h @ wu)) @ wd


def _trunk(x, mem, prm):
    for layer in range(DEPTH):
        i = layer // 2
        g = prm['norm_g'][layer]
        h = _rms_norm(x, g[0])
        if layer % 2 == 0:
            h = _even_mixer(h, prm['ev_w_in'][i], prm['hy_short_w'][i], prm['hy_short_b'][i],
                            prm['hy_w1'][i], prm['hy_b1'][i], prm['hy_freq'][i], prm['hy_w2'][i],
                            prm['hy_b2'][i], prm['hy_w3'][i], prm['hy_skip'][i], prm['hy_out_g'][i],
                            prm['s5_a_re'][i], prm['s5_a_im'][i], prm['s5_log_dt'][i],
                            prm['s5_b_re'][i], prm['s5_b_im'][i], prm['s5_c_re'][i], prm['s5_c_im'][i],
                            prm['s5_d'][i], prm['s5_w_glu'][i])
        else:
            h = _odd_mixer(h, prm['od_w_in'][i], prm['ret_decay'][i], prm['na_rpb'][i])
        x = x + _rms_norm(h @ prm['mix_wo'][layer], g[1])
        h = _memory_cross_attention(_rms_norm(x, g[2]), mem, prm['mem_norm_g'][layer],
                                    prm['xa_wq'][layer], prm['xa_wkv'][layer], prm['xa_wo'][layer])
        x = x + _rms_norm(h, g[3])
        h = _swiglu(_rms_norm(x, g[4]), prm['ffn_wg'][layer], prm['ffn_wu'][layer], prm['ffn_wd'][layer])
        x = x + _rms_norm(h, g[5])
    return x


def setup_inputs(seed: int = 0) -> dict:
    key = jax.random.key(seed)
    ks = iter(jax.random.split(key, 48))
    f32 = jnp.float32

    def nrm(shape, scale):
        return scale * jax.random.normal(next(ks), shape, f32)

    def gain(shape):
        return 1.0 + 0.01 * jax.random.normal(next(ks), shape, f32)

    D = D_MODEL
    ne, no = N_EVEN, N_ODD
    G, P, I = S5_GROUPS, S5_STATE, S5_GROUP
    n_state = jnp.arange(P, dtype=f32)
    ret_base = jnp.log(-jnp.log1p(-jnp.exp2(-5.0 - jnp.arange(RET_HEADS, dtype=f32))))
    return {
        'x_prompt': nrm((BATCH, SEQ, D), 1.0),
        'x_sample': nrm((DEC_BATCH, DEC_SEQ, D), 1.0),
        'mem_prompt': nrm((BATCH, N_MEM, D), 1.0),
        'mem_sample': nrm((DEC_BATCH, N_MEM, D), 1.0),
        'norm_g': gain((DEPTH, 6, D)),
        'mix_wo': nrm((DEPTH, D, D), D ** -0.5),
        'ev_w_in': nrm((ne, D, 3 * HY_WIDTH + S5_WIDTH), D ** -0.5),
        'hy_short_w': nrm((ne, 3, 3 * HY_WIDTH), 3 ** -0.5),
        'hy_short_b': nrm((ne, 3 * HY_WIDTH), 0.01),
        'hy_w1': nrm((ne, HY_EMB, HY_FILTER_HIDDEN), HY_EMB ** -0.5),
        'hy_b1': nrm((ne, HY_FILTER_HIDDEN), 0.02),
        'hy_freq': 1.0 + nrm((ne, 2, HY_FILTER_HIDDEN), 0.1),
        'hy_w2': nrm((ne, HY_FILTER_HIDDEN, HY_FILTER_HIDDEN), HY_FILTER_HIDDEN ** -0.5),
        'hy_b2': nrm((ne, HY_FILTER_HIDDEN), 0.02),
        'hy_w3': nrm((ne, HY_FILTER_HIDDEN, HY_ORDER * 2 * HY_WIDTH), HY_FILTER_HIDDEN ** -0.5),
        'hy_skip': nrm((ne, HY_ORDER, HY_WIDTH), 1.0),
        'hy_out_g': gain((ne, HY_WIDTH)),
        's5_a_re': -0.5 + nrm((ne, 2, G, P), 0.01),
        's5_a_im': math.pi * n_state + nrm((ne, 2, G, P), 0.01),
        's5_log_dt': jax.random.uniform(next(ks), (ne, 2, G), f32, math.log(S5_DT_MIN), math.log(S5_DT_MAX)),
        's5_b_re': nrm((ne, 2, G, P, I), (2 * I) ** -0.5),
        's5_b_im': nrm((ne, 2, G, P, I), (2 * I) ** -0.5),
        's5_c_re': nrm((ne, 2, G, I, P), (2 * P) ** -0.5),
        's5_c_im': nrm((ne, 2, G, I, P), (2 * P) ** -0.5),
        's5_d': nrm((ne, S5_WIDTH), 1.0),
        's5_w_glu': nrm((ne, S5_WIDTH, S5_WIDTH), S5_WIDTH ** -0.5),
        'od_w_in': nrm((no, D, 4 * RET_WIDTH + 3 * NA_WIDTH), D ** -0.5),
        'ret_decay': ret_base + nrm((no, 2, RET_HEADS), 0.01),
        'na_rpb': nrm((no, NA_HEADS, 2 * NA_WIN_ROWS - 1, 2 * NA_WIN_COLS - 1), 0.1),
        'mem_norm_g': gain((DEPTH, D)),
        'xa_wq': nrm((DEPTH, D, D), D ** -0.5),
        'xa_wkv': nrm((DEPTH, D, 2 * D), D ** -0.5),
        'xa_wo': nrm((DEPTH, D, D), D ** -0.5),
        'ffn_wg': nrm((DEPTH, D, FFN_HIDDEN), D ** -0.5),
        'ffn_wu': nrm((DEPTH, D, FFN_HIDDEN), D ** -0.5),
        'ffn_wd': nrm((DEPTH, FFN_HIDDEN, D), FFN_HIDDEN ** -0.5),
    }


def reference(x_prompt, x_sample, mem_prompt, mem_sample, norm_g, mix_wo, ev_w_in, hy_short_w, hy_short_b,
              hy_w1, hy_b1, hy_freq, hy_w2, hy_b2, hy_w3, hy_skip, hy_out_g, s5_a_re, s5_a_im, s5_log_dt,
              s5_b_re, s5_b_im, s5_c_re, s5_c_im, s5_d, s5_w_glu, od_w_in, ret_decay, na_rpb, mem_norm_g,
              xa_wq, xa_wkv, xa_wo, ffn_wg, ffn_wu, ffn_wd):
    prm = {
        'norm_g': norm_g, 'mix_wo': mix_wo, 'ev_w_in': ev_w_in, 'hy_short_w': hy_short_w,
        'hy_short_b': hy_short_b, 'hy_w1': hy_w1, 'hy_b1': hy_b1, 'hy_freq': hy_freq, 'hy_w2': hy_w2,
        'hy_b2': hy_b2, 'hy_w3': hy_w3, 'hy_skip': hy_skip, 'hy_out_g': hy_out_g, 's5_a_re': s5_a_re,
        's5_a_im': s5_a_im, 's5_log_dt': s5_log_dt, 's5_b_re': s5_b_re, 's5_b_im': s5_b_im,
        's5_c_re': s5_c_re, 's5_c_im': s5_c_im, 's5_d': s5_d, 's5_w_glu': s5_w_glu, 'od_w_in': od_w_in,
        'ret_decay': ret_decay, 'na_rpb': na_rpb, 'mem_norm_g': mem_norm_g, 'xa_wq': xa_wq,
        'xa_wkv': xa_wkv, 'xa_wo': xa_wo, 'ffn_wg': ffn_wg, 'ffn_wu': ffn_wu, 'ffn_wd': ffn_wd,
    }
    y_prompt = _trunk(x_prompt, mem_prompt, prm)
    y_sample = _trunk(x_sample, mem_sample, prm)
    return (y_prompt, y_sample)
```

```cpp
#include <hip/hip_runtime.h>
#include <cstdio>
#include <cstdint>

#define LAS __attribute__((address_space(3)))
#define GAS __attribute__((address_space(1)))
typedef unsigned short bf16_t;
typedef short bf16x8 __attribute__((ext_vector_type(8)));
typedef float f32x4 __attribute__((ext_vector_type(4)));
typedef float f32x16 __attribute__((ext_vector_type(16)));
typedef float f32x2 __attribute__((ext_vector_type(2)));
typedef unsigned u32x4 __attribute__((ext_vector_type(4)));
typedef unsigned u32x2 __attribute__((ext_vector_type(2)));
#define MK2(a, b) ((f32x2){(a), (b)})
#define MK4(a, b, c, d) ((f32x4){(a), (b), (c), (d)})

constexpr int D = 2048, NT = 40960, NPROMPT = 32768, DEPTH = 4;
constexpr int HYW = 1536, S5W = 512, FFN = 5632, NMEM = 256, NMEMTOK = 1536;
constexpr int NWG_THREADS = 512;
constexpr int RCL = 9, RC = 1 << RCL, RNCH = NT / RC, RUNITS = RNCH * 8;
constexpr int P_LD = 5120;
constexpr float RMS_EPS = 1e-6f;

constexpr size_t MiB = 1u << 20;
constexpr size_t WS_CTL = 0;
constexpr size_t WS_TW = 1 * MiB;
constexpr size_t WS_ROTC = 2 * MiB, WS_ROTS = 6 * MiB;
constexpr size_t WS_HID2 = 10 * MiB;
constexpr size_t WS_S5T = 13 * MiB;
constexpr size_t WS_MEMN = 14 * MiB, WS_KMEM = 20 * MiB, WS_VT = 26 * MiB;
constexpr size_t WS_W = 32 * MiB;
constexpr size_t W_IN = 0, W_O = 28 * MiB, W_Q = 36 * MiB, W_KV = 44 * MiB, W_XO = 60 * MiB, W_GU = 68 * MiB, W_D = 112 * MiB, W_GLU = 134 * MiB;
constexpr size_t WS_H = 176 * MiB, WS_MIXO = 336 * MiB, WS_TMP = 496 * MiB, WS_BIG = 656 * MiB, WS_X = 1216 * MiB, WS_END = 1376 * MiB;
constexpr size_t HYSCR_PER_WG = 328 * 1024;
constexpr size_t WS_HYSCR = WS_TMP, WS_S5ST = WS_TMP + 96 * MiB;
constexpr size_t BIG_PT = 0, BIG_U5 = 360 * MiB, BIG_SSG = 440 * MiB;
constexpr size_t BIG_P = 0, BIG_VT = 400 * MiB;
constexpr size_t BIG_Q = 0, BIG_S = 160 * MiB, BIG_PB = 320 * MiB, BIG_O = 400 * MiB;
constexpr size_t BIG_HID = 0;
constexpr int CW_BAR = 4096;
constexpr size_t WS_L2G = 512 * 1024;

constexpr int LDS_BYTES = 163840;
constexpr int LDS_MISC = LDS_BYTES - 256;

__device__ __forceinline__ unsigned f2bf(float f) { unsigned u = __builtin_bit_cast(unsigned, f); return (u + 0x7fffu + ((u >> 16) & 1u)) >> 16; }
__device__ __forceinline__ unsigned pk2(float lo, float hi) { unsigned r; asm volatile("v_cvt_pk_bf16_f32 %0, %1, %2" : "=v"(r) : "v"(lo), "v"(hi)); return r; }
__device__ __forceinline__ float bf_lo(unsigned w) { return __builtin_bit_cast(float, w << 16); }
__device__ __forceinline__ float bf_hi(unsigned w) { return __builtin_bit_cast(float, w & 0xffff0000u); }
__device__ __forceinline__ float bf1(bf16_t b) { return __builtin_bit_cast(float, ((unsigned)b) << 16); }
__device__ __forceinline__ float wave_sum(float v) {
#pragma unroll
    for (int o = 1; o < 64; o <<= 1) v += __shfl_xor(v, o);
    return v;
}
__device__ __forceinline__ float wave_max(float v) {
#pragma unroll
    for (int o = 1; o < 64; o <<= 1) v = fmaxf(v, __shfl_xor(v, o));
    return v;
}
#define LDS_WAIT() asm volatile("s_waitcnt lgkmcnt(0)" ::: "memory")
#define VM_WAIT() asm volatile("s_waitcnt vmcnt(0)" ::: "memory")

__device__ __forceinline__ void tok_info(int t, int& seq, int& l, int& L) {
    if (t < NPROMPT) { seq = t >> 13; l = t & 8191; L = 8192; } else { const int u = t - NPROMPT; seq = 4 + (u >> 12); l = u & 4095; L = 4096; }
}

#define XB_TMO      128
#define XB_XCNT(j)  (256  + 64 * (j))
#define XB_XSUB(j)  (1280 + 64 * (j))
#define XB_XGEN(j)  (2304 + 64 * (j))
#define XB_TOP      3328
#define XB_TOPGEN   3392
#define XCD_BAR_WORDS 3456
#define XB_SPIN_CAP (1u << 22)
__device__ __forceinline__ unsigned xb_ld(unsigned* p)              { return __hip_atomic_load(p, __ATOMIC_RELAXED, __HIP_MEMORY_SCOPE_AGENT); }
__device__ __forceinline__ unsigned xb_add(unsigned* p, unsigned v) { return __hip_atomic_fetch_add(p, v, __ATOMIC_RELAXED, __HIP_MEMORY_SCOPE_AGENT); }
__device__ __forceinline__ unsigned xb_xcc_id() { return (unsigned)__builtin_amdgcn_s_getreg((3 << 11) | 20) & 0xFu; }
#define XB_SPIN(cond, bar) do { unsigned _sp = 0; while (cond) { __builtin_amdgcn_s_sleep(1); \
    if ((++_sp & 255u) == 0u) { if (xb_ld(&(bar)[XB_TMO])) break; if (_sp > XB_SPIN_CAP) { atomicAdd(&(bar)[XB_TMO], 1u); break; } } } } while (0)
struct XcdBarrier { unsigned* bar; unsigned x; volatile LAS unsigned* st; };
__device__ __forceinline__ XcdBarrier xcd_barrier_post(unsigned* bar, volatile LAS unsigned* st, const bool t0) {
    XcdBarrier b; b.bar = bar; b.x = xb_xcc_id(); b.st = st;
    if (t0) (void)xb_add(&bar[XB_XCNT(b.x)], 1u);
    return b;
}
__device__ __forceinline__ void xcd_barrier_complete(unsigned* bar, unsigned x, unsigned& nloc, unsigned& nx) {
    const unsigned G = gridDim.x * gridDim.y * gridDim.z;
    unsigned sum, cnt, mine, sp = 0u;
    for (;;) {
        sum = 0u; cnt = 0u; mine = 0u;
#pragma unroll
        for (unsigned j = 0; j < 16; ++j) { const unsigned c = xb_ld(&bar[XB_XCNT(j)]); sum += c; cnt += (c > 0u) ? 1u : 0u; mine = (j == x) ? c : mine; }
        if (sum == G) break;
        __builtin_amdgcn_s_sleep(1);
        if ((++sp & 255u) == 0u) { if (xb_ld(&bar[XB_TMO])) break; if (sp > XB_SPIN_CAP) { atomicAdd(&bar[XB_TMO], 1u); break; } }
    }
    nloc = mine > 0u ? mine : 1u; nx = cnt > 0u ? cnt : 1u;
}
__device__ __forceinline__ void xcd_barrier(const XcdBarrier& b, const bool t0) {
    asm volatile("s_waitcnt vmcnt(0)" ::: "memory");
    __syncthreads();
    if (t0) {
        unsigned* bar = b.bar;
        __builtin_amdgcn_s_waitcnt(0);
        unsigned nloc = b.st[0], nx = b.st[1];
        if (nloc == 0u) { xcd_barrier_complete(bar, b.x, nloc, nx); b.st[0] = nloc; b.st[1] = nx; }
        const unsigned old = xb_add(&bar[XB_XSUB(b.x)], 1u);
        const unsigned gen = old / nloc;
        if (old + 1u == (gen + 1u) * nloc) {
            __builtin_amdgcn_fence(__ATOMIC_RELEASE, "agent");
            asm volatile("s_waitcnt vmcnt(0)" ::: "memory");
            const unsigned og = xb_add(&bar[XB_TOP], 1u);
            const unsigned tg = og / nx;
            if (og + 1u == (tg + 1u) * nx) xb_add(&bar[XB_TOPGEN], 1u);
            else XB_SPIN(xb_ld(&bar[XB_TOPGEN]) == tg, bar);
            __builtin_amdgcn_fence(__ATOMIC_ACQUIRE, "agent");
            xb_add(&bar[XB_XGEN(b.x)], 1u);
            asm volatile("s_waitcnt vmcnt(0)" ::: "memory");
        } else {
            XB_SPIN(xb_ld(&bar[XB_XGEN(b.x)]) == gen, bar);
            __builtin_amdgcn_fence(__ATOMIC_ACQUIRE, "agent");
            asm volatile("s_waitcnt vmcnt(0)" ::: "memory");
        }
    }
    __syncthreads();
}

namespace pg8 {
constexpr int BM = 256, BK = 64, HALF = 128, HTB = HALF * BK * 2, STAGE_BYTES = 8 * HTB, NXCD = 8, WGM = 8;
__host__ __device__ __forceinline__ int lds_byte(int r, int c) { const int st = (r >> 4) * 2 + (c >> 5), rr = r & 15, cc = c & 31, ob = rr * 64 + cc * 2; return st * 1024 + (ob ^ (((ob >> 9) & 1) << 5)); }
__host__ __device__ __forceinline__ void stage_rc(int b, int& R, int& C) { const int st = b / 1024, sb = b % 1024, swz = sb ^ (((sb >> 9) & 1) << 5); R = (st >> 1) * 16 + swz / 64; C = (st & 1) * 32 + (swz % 64) / 2; }
__host__ __device__ __forceinline__ int perm32(int rho) { const int n = rho >> 4, i = rho & 15; return 8 * (i >> 2) + 4 * n + (i & 3); }
struct Unit { int pm, pn, z; };

struct StdSched {
    const char* A; const char* Bt; size_t tsA, tsB; int nM, nN, nwg, G, c;
    __device__ __forceinline__ void init(const bf16_t* A_, int lda, int M, const bf16_t* Bt_, int ldb, int N, int G_, int c_) {
        A = (const char*)A_; Bt = (const char*)Bt_; tsA = (size_t)BM * lda * 2; tsB = (size_t)BM * ldb * 2; nM = M / BM; nN = N / BM; nwg = nM * nN; G = G_; c = c_; }
    __device__ __forceinline__ bool next(int i, Unit& u) const {
        const long L = (long)i * G + c; if (L >= nwg) return false;
        int wgid = (int)L; { const int q = nwg / NXCD, r = nwg % NXCD, xcd = wgid % NXCD, off = wgid / NXCD; wgid = (xcd < r ? xcd * (q + 1) : r * (q + 1) + (xcd - r) * q) + off; }
        const int nig = WGM * nN, gid = wgid / nig, fm = gid * WGM, gsz = (nM - fm) < WGM ? (nM - fm) : WGM;
        u.pm = fm + ((wgid % nig) % gsz); u.pn = (wgid % nig) / gsz; u.z = 0; return true;
    }
    __device__ __forceinline__ const char* a_ptr(const Unit& u) const { return A + (size_t)u.pm * tsA; }
    __device__ __forceinline__ const char* b_ptr(const Unit& u) const { return Bt + (size_t)u.pn * tsB; }
};
__device__ __forceinline__ int seq_of_tile(int pmg) { return pmg < 128 ? (pmg >> 5) : 4 + ((pmg - 128) >> 4); }
struct QKSched {
    const char* Q; const char* Km; int G, c;
    __device__ __forceinline__ bool next(int i, Unit& u) const { const int idx = i * G + c; if (idx >= 640) return false; u.z = idx & 3; u.pm = idx >> 2; u.pn = 0; return true; }
    __device__ __forceinline__ const char* a_ptr(const Unit& u) const { return Q + ((size_t)u.pm * 256 * D + (size_t)u.z * 512) * 2; }
    __device__ __forceinline__ const char* b_ptr(const Unit& u) const { return Km + ((size_t)seq_of_tile(u.pm) * 256 * D + (size_t)u.z * 512) * 2; }
};
struct PVSched {
    const char* P; const char* VT; int G, c;
    __device__ __forceinline__ bool next(int i, Unit& u) const { const int idx = i * G + c; if (idx >= 1280) return false; u.pn = idx & 1; u.z = (idx >> 1) & 3; u.pm = idx >> 3; return true; }
    __device__ __forceinline__ const char* a_ptr(const Unit& u) const { return P + ((size_t)u.pm * 256 * 1024 + (size_t)u.z * 256) * 2; }
    __device__ __forceinline__ const char* b_ptr(const Unit& u) const { return VT + ((size_t)(u.z * 512 + u.pn * 256) * NMEMTOK + (size_t)seq_of_tile(u.pm) * 256) * 2; }
};

struct EpiBf16 {
    static constexpr bool PERM = true;
    bf16_t* O; int ldc; int zcol;
    __device__ __forceinline__ void operator()(const f32x4 (&acc)[2][2][4][2], const Unit& u, int wr, int wc, int fr, int fq) const {
        const int row0 = u.pm * BM + wr * 64 + fr; const int col0 = u.pn * BM + u.z * zcol + wc * 32 + 8 * fq;
#pragma unroll
        for (int ai = 0; ai < 2; ++ai)
#pragma unroll
            for (int m = 0; m < 4; ++m) { bf16_t* rowp = O + (size_t)(row0 + ai * HALF + m * 16) * ldc + col0;
#pragma unroll
                for (int bj = 0; bj < 2; ++bj) { const f32x4 v0 = acc[ai][bj][m][0], v1 = acc[ai][bj][m][1];
                    u32x4 w; w.x = pk2(v0[0], v0[1]); w.y = pk2(v0[2], v0[3]); w.z = pk2(v1[0], v1[1]); w.w = pk2(v1[2], v1[3]);
                    *(u32x4*)(rowp + bj * HALF) = w; } }
    }
};
struct EpiF32 {
    static constexpr bool PERM = false;
    float* C; int ldc; int zcol; float scale;
    __device__ __forceinline__ void operator()(const f32x4 (&acc)[2][2][4][2], const Unit& u, int wr, int wc, int fr, int fq) const {
        const int row0 = u.pm * BM + wr * 64 + fr, col0 = u.pn * BM + u.z * zcol + wc * 32 + 4 * fq;
#pragma unroll
        for (int ai = 0; ai < 2; ++ai)
#pragma unroll
            for (int m = 0; m < 4; ++m) { float* rowp = C + (size_t)(row0 + ai * HALF + m * 16) * ldc + col0;
#pragma unroll
                for (int bj = 0; bj < 2; ++bj)
#pragma unroll
                    for (int n = 0; n < 2; ++n) *(f32x4*)(rowp + bj * HALF + n * 16) = acc[ai][bj][m][n] * scale; }
    }
};
struct EpiSwiGLU {
    static constexpr bool PERM = false;
    bf16_t* O; int ldc;
    __device__ __forceinline__ void operator()(const f32x4 (&acc)[2][2][4][2], const Unit& u, int wr, int wc, int fr, int fq) const {
        const int row0 = u.pm * BM + wr * 64 + fr; const int colh = (u.pn * BM + wc * 32) / 2 + 4 * fq;
#pragma unroll
        for (int ai = 0; ai < 2; ++ai)
#pragma unroll
            for (int m = 0; m < 4; ++m) { bf16_t* rowp = O + (size_t)(row0 + ai * HALF + m * 16) * ldc + colh;
#pragma unroll
                for (int bj = 0; bj < 2; ++bj) { const f32x4 g = acc[ai][bj][m][0], up = acc[ai][bj][m][1]; float o[4];
#pragma unroll
                    for (int j = 0; j < 4; ++j) { const float s = g[j] * __builtin_amdgcn_rcpf(1.0f + __builtin_amdgcn_exp2f(-1.4426950408889634f * g[j])); o[j] = s * up[j]; }
                    u32x2 w; w.x = pk2(o[0], o[1]); w.y = pk2(o[2], o[3]);
                    *(u32x2*)(rowp + bj * (HALF / 2)) = w; } }
    }
};
struct EpiGLU {
    static constexpr bool PERM = true;
    const bf16_t* G; bf16_t* O; int ldg, ldo, ocol;
    __device__ __forceinline__ void operator()(const f32x4 (&acc)[2][2][4][2], const Unit& u, int wr, int wc, int fr, int fq) const {
        const int row0 = u.pm * BM + wr * 64 + fr; const int col0 = u.pn * BM + wc * 32 + 8 * fq;
#pragma unroll
        for (int ai = 0; ai < 2; ++ai)
#pragma unroll
            for (int m = 0; m < 4; ++m) { const size_t r = (size_t)(row0 + ai * HALF + m * 16);
                const u32x4 gv2[2] = {*(const u32x4*)(G + r * ldg + col0), *(const u32x4*)(G + r * ldg + col0 + HALF)};
#pragma unroll
                for (int bj = 0; bj < 2; ++bj) { const f32x4 v0 = acc[ai][bj][m][0], v1 = acc[ai][bj][m][1];
                    const u32x4 gv = gv2[bj];
                    float o[8]; const float a[8] = {v0[0], v0[1], v0[2], v0[3], v1[0], v1[1], v1[2], v1[3]};
                    const float y[8] = {bf_lo(gv.x), bf_hi(gv.x), bf_lo(gv.y), bf_hi(gv.y), bf_lo(gv.z), bf_hi(gv.z), bf_lo(gv.w), bf_hi(gv.w)};
#pragma unroll
                    for (int j = 0; j < 8; ++j) o[j] = y[j] / (1.0f + __expf(-a[j]));
                    u32x4 w; w.x = pk2(o[0], o[1]); w.y = pk2(o[2], o[3]); w.z = pk2(o[4], o[5]); w.w = pk2(o[6], o[7]);
                    *(u32x4*)(O + r * ldo + ocol + col0 + bj * HALF) = w; } }
    }
};
struct EpiRot {
    static constexpr bool PERM = true;
    bf16_t* O; int ldc; const float* rc; const float* rs;
    bf16_t* Kf; const float* rd;
    __device__ __forceinline__ void operator()(const f32x4 (&acc)[2][2][4][2], const Unit& u, int wr, int wc, int fr, int fq) const {
        const int row0 = u.pm * BM + wr * 64 + fr; const int col0 = u.pn * BM + wc * 32 + 8 * fq; const bool rot = u.pn < 8; const bool kt = (u.pn >> 2) == 1;
        const int head = u.pn & 3; float l2f = 0.f, l2b = 0.f; if (kt) { l2f = rd[head]; l2b = rd[4 + head]; }
#pragma unroll
        for (int ai = 0; ai < 2; ++ai)
#pragma unroll
            for (int m = 0; m < 4; ++m) { const int r = row0 + ai * HALF + m * 16; bf16_t* rowp = O + (size_t)r * ldc + col0;
                const int pos = (r < NPROMPT) ? (r & 8191) : ((r - NPROMPT) & 4095); const unsigned toff = (unsigned)(pos * 128 + wc * 32 + 8 * fq);
                u32x4 wa, wb;
#pragma unroll
                for (int n = 0; n < 2; ++n) { f32x4 a = acc[ai][0][m][n], b = acc[ai][1][m][n];
                    if (rot) { const f32x4 c = *(const f32x4*)(rc + toff + 4 * n), sn = *(const f32x4*)(rs + toff + 4 * n); const f32x4 x = a * c - b * sn, y = a * sn + b * c; a = x; b = y; }
                    if (n == 0) { wa.x = pk2(a[0], a[1]); wa.y = pk2(a[2], a[3]); wb.x = pk2(b[0], b[1]); wb.y = pk2(b[2], b[3]); }
                    else { wa.z = pk2(a[0], a[1]); wa.w = pk2(a[2], a[3]); wb.z = pk2(b[0], b[1]); wb.w = pk2(b[2], b[3]); }
                    if (kt) {
                        const int ic = r & (RC - 1); const float ff = __builtin_amdgcn_exp2f(l2f * (float)(RC - 1 - ic)), fb = __builtin_amdgcn_exp2f(l2b * (float)ic);
                        bf16_t* kp = Kf + (size_t)(head * 256 + wc * 32 + 8 * fq + 4 * n) * NT + r;
#pragma unroll
                        for (int j = 0; j < 4; ++j) {
                            kp[(size_t)j * NT] = (bf16_t)pk2(a[j] * ff, 0.f); kp[(size_t)(j + 128) * NT] = (bf16_t)pk2(b[j] * ff, 0.f);
                            kp[(size_t)(1024 + j) * NT] = (bf16_t)pk2(a[j] * fb, 0.f); kp[(size_t)(1024 + j + 128) * NT] = (bf16_t)pk2(b[j] * fb, 0.f); } } }
                *(u32x4*)(rowp) = wa; *(u32x4*)(rowp + HALF) = wb;
                asm volatile("" ::: "memory"); }
    }
};

struct RetUSched {
    const char* vT; const char* kTf; const char* kTb; int G, c;
    __device__ __forceinline__ bool next(int i, Unit& u) const { const int idx = i * G + c; if (idx >= RUNITS) return false; u.pm = idx; u.pn = 0; u.z = 0; return true; }
    __device__ __forceinline__ const char* a_ptr(const Unit& u) const { const int head = (u.pm >> 1) & 3, chunk = u.pm >> 3; return vT + ((size_t)(head * 256) * NT + (size_t)chunk * RC) * 2; }
    __device__ __forceinline__ const char* b_ptr(const Unit& u) const { const int head = (u.pm >> 1) & 3, chunk = u.pm >> 3; return ((u.pm & 1) ? kTb : kTf) + ((size_t)(head * 256) * NT + (size_t)chunk * RC) * 2; }
};
struct RetISched {
    const LAS unsigned long long* slots; int G, c;
    __device__ __forceinline__ const char* base(int i) const { const unsigned long long v = slots[i]; const unsigned lo = __builtin_amdgcn_readfirstlane((unsigned)v), hi = __builtin_amdgcn_readfirstlane((unsigned)(v >> 32));
        return (const char*)(const GAS char*)(((unsigned long long)hi << 32) | lo); }
    __device__ __forceinline__ bool next(int i, Unit& u) const { const int idx = i * G + c; if (idx >= 1280) return false; u.z = idx & 7; u.pm = idx >> 3; u.pn = 0; return true; }
    __device__ __forceinline__ const char* a_ptr(const Unit& u) const { return base(0) + ((size_t)u.pm * 256 * P_LD + (size_t)(u.z >> 1) * 256) * 2; }
    __device__ __forceinline__ const char* b_ptr(const Unit& u) const { return base(1) + (size_t)(((u.pm >> (RCL - 8)) * 4 + (u.z >> 1)) * 2 + (u.z & 1)) * 65536 * 2; }
};
struct EpiInter {
    static constexpr bool PERM = true;
    bf16_t* Of; const float* rd;
    __device__ __forceinline__ void operator()(const f32x4 (&acc)[2][2][4][2], const Unit& u, int wr, int wc, int fr, int fq) const {
        const int head = u.z >> 1, dir = u.z & 1; const float l2 = rd[dir * 4 + head]; bf16_t* O = Of + (size_t)dir * NT * 1024;
        const int row0 = u.pm * BM + wr * 64 + fr; const int col0 = head * 256 + wc * 32 + 8 * fq;
#pragma unroll
        for (int ai = 0; ai < 2; ++ai)
#pragma unroll
            for (int m = 0; m < 4; ++m) { const int r = row0 + ai * HALF + m * 16, i = r & (RC - 1); const float sc = __builtin_amdgcn_exp2f(l2 * (float)(dir ? RC - i : i + 1));
                bf16_t* rowp = O + (size_t)r * 1024 + col0;
#pragma unroll
                for (int bj = 0; bj < 2; ++bj) { const f32x4 v0 = acc[ai][bj][m][0] * sc, v1 = acc[ai][bj][m][1] * sc;
                    u32x4 w; w.x = pk2(v0[0], v0[1]); w.y = pk2(v0[2], v0[3]); w.z = pk2(v1[0], v1[1]); w.w = pk2(v1[2], v1[3]);
                    *(u32x4*)(rowp + bj * HALF) = w; }
                asm volatile("" ::: "memory"); __builtin_amdgcn_sched_barrier(0); }
    }
};
struct EpiKT {
    static constexpr bool PERM = true;
    bf16_t* Kf; bf16_t* Kb; const float* rc; const float* rs; const float* rd;
    __device__ __forceinline__ void operator()(const f32x4 (&acc)[2][2][4][2], const Unit& u, int wr, int wc, int fr, int fq) const {
        const int head = u.pm; const float l2f = rd[head], l2b = rd[4 + head];
#pragma unroll
        for (int bj = 0; bj < 2; ++bj)
#pragma unroll
            for (int n = 0; n < 2; ++n) { const int tok0 = u.pn * BM + bj * HALF + wc * 32 + 8 * fq + 4 * n;
                float ff[4], fb[4]; int tof[4];
#pragma unroll
                for (int j = 0; j < 4; ++j) { const int t = tok0 + j, pos = (t < NPROMPT) ? (t & 8191) : ((t - NPROMPT) & 4095), ic = t & (RC - 1);
                    ff[j] = __builtin_amdgcn_exp2f(l2f * (float)(RC - 1 - ic)); fb[j] = __builtin_amdgcn_exp2f(l2b * (float)ic); tof[j] = pos * 128; }
#pragma unroll
                for (int m = 0; m < 4; ++m) { const int il = wr * 64 + m * 16 + fr;
                    const f32x4 x1 = acc[0][bj][m][n], x2 = acc[1][bj][m][n]; float y1[4], y2[4];
#pragma unroll
                    for (int j = 0; j < 4; ++j) { const float c = rc[tof[j] + il], s = rs[tof[j] + il]; y1[j] = x1[j] * c - x2[j] * s; y2[j] = x1[j] * s + x2[j] * c; }
                    const size_t o1 = (size_t)(head * 256 + il) * NT + tok0, o2 = o1 + (size_t)128 * NT;
                    u32x2 w;
                    w.x = pk2(y1[0] * ff[0], y1[1] * ff[1]); w.y = pk2(y1[2] * ff[2], y1[3] * ff[3]); *(u32x2*)(Kf + o1) = w;
                    w.x = pk2(y2[0] * ff[0], y2[1] * ff[1]); w.y = pk2(y2[2] * ff[2], y2[3] * ff[3]); *(u32x2*)(Kf + o2) = w;
                    w.x = pk2(y1[0] * fb[0], y1[1] * fb[1]); w.y = pk2(y1[2] * fb[2], y1[3] * fb[3]); *(u32x2*)(Kb + o1) = w;
                    w.x = pk2(y2[0] * fb[0], y2[1] * fb[1]); w.y = pk2(y2[2] * fb[2], y2[3] * fb[3]); *(u32x2*)(Kb + o2) = w;
                    asm volatile("" ::: "memory"); __builtin_amdgcn_sched_barrier(0); }
            }
    }
};

template <class Epi, class Sched>
__device__ __forceinline__ void gemm_phase(LAS unsigned char* lds, const int tid, const int K, const int lda, const int ldb, const Sched& S, const Epi& E) {
    const int wid = __builtin_amdgcn_readfirstlane(tid >> 6), lane = tid & 63, wr = wid >> 2, wc = wid & 3, fr = lane & 15, fq = lane >> 4;
    const int nt = K / BK;
    unsigned voffA[2], voffB[2];
#pragma unroll
    for (int i = 0; i < 2; ++i) { int R, C; stage_rc(tid * 16 + i * 8192, R, C); const int Rb = Epi::PERM ? ((R & ~31) + perm32(R & 31)) : R;
        voffA[i] = (unsigned)(R * lda + C) * 2u; voffB[i] = (unsigned)(Rb * ldb + C) * 2u; }
    const size_t kstep = (size_t)(BK * 2);
    const size_t hstepA = (size_t)HALF * lda * 2, hstepB = (size_t)HALF * ldb * 2;
    const unsigned ldsw = (unsigned)wid * 1024u;
    const int aoff = lds_byte(wr * 64 + fr, fq * 8), boff = lds_byte(wc * 32 + fr, fq * 8);
#define PG8_SA(b, h) (((b) * 2 + (h)) * HTB)
#define PG8_SB(b, h) ((4 + (b) * 2 + (h)) * HTB)
#define PG8_STAGE(bufoff, gbase, voff) do { _Pragma("unroll") for (int _i = 0; _i < 2; ++_i) \
        __builtin_amdgcn_global_load_lds((const unsigned*)((const char*)(gbase) + (voff)[_i]), (LAS unsigned*)(lds + (bufoff) + ldsw + _i * 8192), 16, 0, 0); } while (0)
#define PG8_LDA(dst, b, h) do { _Pragma("unroll") for (int m = 0; m < 4; ++m) _Pragma("unroll") for (int k = 0; k < 2; ++k) dst[m][k] = *(const LAS bf16x8*)(lds + PG8_SA(b, h) + aoff + m * 2048 + k * 1024); } while (0)
#define PG8_LDB(dst, b, h) do { _Pragma("unroll") for (int n = 0; n < 2; ++n) _Pragma("unroll") for (int k = 0; k < 2; ++k) dst[n][k] = *(const LAS bf16x8*)(lds + PG8_SB(b, h) + boff + n * 2048 + k * 1024); } while (0)
#define PG8_MMA(ai, bj, At, Bt) do { __builtin_amdgcn_s_setprio(1); _Pragma("unroll") for (int m = 0; m < 4; ++m) _Pragma("unroll") for (int n = 0; n < 2; ++n) _Pragma("unroll") for (int k = 0; k < 2; ++k) \
        acc[ai][bj][m][n] = __builtin_amdgcn_mfma_f32_16x16x32_bf16(Bt[n][k], At[m][k], acc[ai][bj][m][n], 0, 0, 0); __builtin_amdgcn_s_setprio(0); } while (0)
#define PG8_WAIT_V(n) asm volatile("s_waitcnt vmcnt(" #n ")" ::: "memory")
#define PG8_WAIT_L(n) asm volatile("s_waitcnt lgkmcnt(" #n ")" ::: "memory")
#define PG8_BAR __builtin_amdgcn_s_barrier()
#define PG8_SCHED __builtin_amdgcn_sched_barrier(0)
    Unit cur, nxt; int ui = 0;
    if (!S.next(0, cur)) return;
    f32x4 acc[2][2][4][2];
#pragma unroll
    for (int a = 0; a < 2; ++a)
#pragma unroll
        for (int b = 0; b < 2; ++b)
#pragma unroll
            for (int m = 0; m < 4; ++m)
#pragma unroll
                for (int n = 0; n < 2; ++n) acc[a][b][m][n] = (f32x4){0.f, 0.f, 0.f, 0.f};
    bf16x8 At[4][2], B0[2][2], B1[2][2];
    const char* cA = S.a_ptr(cur); const char* cB = S.b_ptr(cur);
    PG8_STAGE(PG8_SB(0, 0), cB, voffB); PG8_STAGE(PG8_SA(0, 0), cA, voffA); PG8_STAGE(PG8_SB(0, 1), cB + hstepB, voffB); PG8_STAGE(PG8_SA(0, 1), cA + hstepA, voffA);
    if (wr == 1) PG8_BAR;
    PG8_WAIT_V(4); PG8_BAR;
    PG8_STAGE(PG8_SB(1, 0), cB + kstep, voffB); PG8_STAGE(PG8_SA(1, 0), cA + kstep, voffA); PG8_STAGE(PG8_SB(1, 1), cB + hstepB + kstep, voffB);
    PG8_WAIT_V(6); PG8_BAR;
    for (;;) {
        const bool has_next = S.next(ui + 1, nxt);
        const char* nA = has_next ? S.a_ptr(nxt) : cA; const char* nB = has_next ? S.b_ptr(nxt) : cB;
        for (int t = 0; t < nt; t += 2) {
            const bool last = (t == nt - 2);
            const char* a1 = cA + (size_t)(t + 1) * kstep;
            const char* a2 = last ? nA : cA + (size_t)(t + 2) * kstep; const char* b2 = last ? nB : cB + (size_t)(t + 2) * kstep;
            const char* a3 = a2 + kstep; const char* b3 = b2 + kstep;
            PG8_LDB(B0, 0, 0); PG8_SCHED; PG8_LDA(At, 0, 0); PG8_STAGE(PG8_SA(1, 1), a1 + hstepA, voffA);
            PG8_WAIT_L(8); PG8_BAR; PG8_WAIT_L(0); PG8_MMA(0, 0, At, B0); PG8_BAR; PG8_SCHED;
            PG8_LDB(B1, 0, 1); PG8_STAGE(PG8_SB(0, 0), b2, voffB);
            PG8_BAR; PG8_WAIT_L(0); PG8_MMA(0, 1, At, B1); PG8_BAR;
            PG8_LDA(At, 0, 1); PG8_STAGE(PG8_SA(0, 0), a2, voffA);
            PG8_BAR; PG8_WAIT_L(0); PG8_MMA(1, 0, At, B0); PG8_BAR; PG8_SCHED;
            PG8_STAGE(PG8_SB(0, 1), b2 + hstepB, voffB);
            PG8_WAIT_V(6); PG8_BAR; PG8_MMA(1, 1, At, B1); PG8_BAR;
            PG8_LDB(B0, 1, 0); PG8_SCHED; PG8_LDA(At, 1, 0); PG8_STAGE(PG8_SA(0, 1), a2 + hstepA, voffA);
            PG8_WAIT_L(8); PG8_BAR; PG8_WAIT_L(0); PG8_MMA(0, 0, At, B0); PG8_BAR; PG8_SCHED;
            PG8_LDB(B1, 1, 1); PG8_STAGE(PG8_SB(1, 0), b3, voffB);
            PG8_BAR; PG8_WAIT_L(0); PG8_MMA(0, 1, At, B1); PG8_BAR;
            PG8_LDA(At, 1, 1); PG8_STAGE(PG8_SA(1, 0), a3, voffA);
            PG8_BAR; PG8_WAIT_L(0); PG8_MMA(1, 0, At, B0); PG8_BAR; PG8_SCHED;
            PG8_STAGE(PG8_SB(1, 1), b3 + hstepB, voffB);
            PG8_WAIT_V(6); PG8_BAR; PG8_MMA(1, 1, At, B1); PG8_BAR;
        }
        E(acc, cur, wr, wc, fr, fq);
        if (!has_next) break;
#pragma unroll
        for (int a = 0; a < 2; ++a)
#pragma unroll
            for (int b = 0; b < 2; ++b)
#pragma unroll
                for (int m = 0; m < 4; ++m)
#pragma unroll
                    for (int n = 0; n < 2; ++n) acc[a][b][m][n] = (f32x4){0.f, 0.f, 0.f, 0.f};
        cur = nxt; cA = nA; cB = nB; ++ui;
    }
    PG8_WAIT_V(0);
    if (wr == 0) PG8_BAR;
    PG8_BAR;
#undef PG8_SA
#undef PG8_SB
#undef PG8_STAGE
#undef PG8_LDA
#undef PG8_LDB
#undef PG8_MMA
#undef PG8_WAIT_V
#undef PG8_WAIT_L
#undef PG8_BAR
#undef PG8_SCHED
}
}

struct MapId { int row_off; __device__ __forceinline__ int operator()(int n, float& sc) const { sc = 1.0f; return n + row_off; } };
struct MapOdd { __device__ __forceinline__ int operator()(int n, float& sc) const {
    const int seg = n >> 10, w = n & 1023; sc = (seg == 1) ? 0.0625f : (seg == 4 ? 0.125f : 1.0f);
    const int dseg = (seg == 0) ? 0 : (seg == 1) ? 1 : (seg == 2) ? 5 : (seg == 3) ? 2 : (seg == 4) ? 3 : (seg == 5) ? 4 : 6;
    return dseg * 1024 + w; } };
struct MapGU { int up; __device__ __forceinline__ int operator()(int n, float& sc) const { sc = 1.0f; return (n >> 4) * 32 + (n & 15) + up * 16; } };

template <class Map>
__device__ __forceinline__ void wt_item(const float* W, int K, int N, bf16_t* WT, const Map& map, LAS float* scr, int item, int lane) {
    const int nblk = N / 32, kb = item / nblk, nb = item % nblk, k0 = 64 * kb, n0 = 32 * nb;
#pragma unroll 8
    for (int i = 0; i < 32; ++i) { const int kk = 2 * i + (lane >> 5); scr[kk * 33 + (lane & 31)] = W[(size_t)(k0 + kk) * N + n0 + (lane & 31)]; }
    LDS_WAIT(); asm volatile("" ::: "memory");
    const int c = lane & 7;
#pragma unroll
    for (int j = 0; j < 4; ++j) { const int n = (lane >> 3) + 8 * j; const LAS float* s = scr + (8 * c) * 33 + n; float sc; const int drow = map(n0 + n, sc);
        u32x4 o; o.x = pk2(s[0 * 33] * sc, s[1 * 33] * sc); o.y = pk2(s[2 * 33] * sc, s[3 * 33] * sc); o.z = pk2(s[4 * 33] * sc, s[5 * 33] * sc); o.w = pk2(s[6 * 33] * sc, s[7 * 33] * sc);
        *(u32x4*)(WT + (size_t)drow * K + k0 + 8 * c) = o; }
    LDS_WAIT(); asm volatile("" ::: "memory");
}
template <class Map>
__device__ __forceinline__ void wt_matrix(const float* W, int K, int N, bf16_t* WT, const Map& map, LAS float* scr, int gw, int NGW, int lane) {
    const int nitems = (K / 64) * (N / 32);
    for (int it = gw; it < nitems; it += NGW) wt_item(W, K, N, WT, map, scr, it, lane);
}

__device__ __forceinline__ void unpack8(const u32x4 w, float (&v)[8]) { v[0] = bf_lo(w.x); v[1] = bf_hi(w.x); v[2] = bf_lo(w.y); v[3] = bf_hi(w.y); v[4] = bf_lo(w.z); v[5] = bf_hi(w.z); v[6] = bf_lo(w.w); v[7] = bf_hi(w.w); }
__device__ __forceinline__ u32x4 pack8(const float (&v)[8]) { u32x4 w; w.x = pk2(v[0], v[1]); w.y = pk2(v[2], v[3]); w.z = pk2(v[4], v[5]); w.w = pk2(v[6], v[7]); return w; }
template <int MODE>
__device__ __forceinline__ void nrn_phase(const float* xin_p, const float* xin_s, bf16_t* xb, float* xout, const bf16_t* tmp, const float* gA, const float* gB, bf16_t* h, int gw, int NGW, int lane) {
    constexpr int R = 2;
    for (int row0 = gw; row0 < NT; row0 += R * NGW) {
        float xv[R][4][8], tv[R][4][8];
#pragma unroll
        for (int q = 0; q < R; ++q) { const int row = row0 + q * NGW; if (row < NT) {
            if (MODE == 0) { const float* src = row < NPROMPT ? xin_p + (size_t)row * D : xin_s + (size_t)(row - NPROMPT) * D;
#pragma unroll
                for (int j = 0; j < 4; ++j) { const f32x4 a = *(const f32x4*)(src + 8 * lane + 512 * j), b = *(const f32x4*)(src + 8 * lane + 512 * j + 4);
                    xv[q][j][0] = a[0]; xv[q][j][1] = a[1]; xv[q][j][2] = a[2]; xv[q][j][3] = a[3]; xv[q][j][4] = b[0]; xv[q][j][5] = b[1]; xv[q][j][6] = b[2]; xv[q][j][7] = b[3]; } }
            else {
#pragma unroll
                for (int j = 0; j < 4; ++j) { unpack8(*(const u32x4*)(xb + (size_t)row * D + 8 * lane + 512 * j), xv[q][j]); unpack8(*(const u32x4*)(tmp + (size_t)row * D + 8 * lane + 512 * j), tv[q][j]); } } } }
#pragma unroll
        for (int q = 0; q < R; ++q) { const int row = row0 + q * NGW; if (row < NT) {
            if (MODE != 0) {
                float ss = 0.f;
#pragma unroll
                for (int j = 0; j < 4; ++j)
#pragma unroll
                    for (int e = 0; e < 8; ++e) ss += tv[q][j][e] * tv[q][j][e];
                const float rstd = 1.0f / sqrtf(wave_sum(ss) * (1.0f / D) + RMS_EPS);
#pragma unroll
                for (int j = 0; j < 4; ++j) { const f32x4 ga = *(const f32x4*)(gA + 8 * lane + 512 * j), gb = *(const f32x4*)(gA + 8 * lane + 512 * j + 4);
                    const float g8[8] = {ga[0], ga[1], ga[2], ga[3], gb[0], gb[1], gb[2], gb[3]};
#pragma unroll
                    for (int e = 0; e < 8; ++e) xv[q][j][e] += tv[q][j][e] * rstd * g8[e]; }
            }
            if (MODE == 2) {
#pragma unroll
                for (int j = 0; j < 4; ++j) { float* dst = xout + (size_t)row * D + 8 * lane + 512 * j;
                    *(f32x4*)dst = (f32x4){xv[q][j][0], xv[q][j][1], xv[q][j][2], xv[q][j][3]}; *(f32x4*)(dst + 4) = (f32x4){xv[q][j][4], xv[q][j][5], xv[q][j][6], xv[q][j][7]}; }
            } else {
                float ss = 0.f;
#pragma unroll
                for (int j = 0; j < 4; ++j) { *(u32x4*)(xb + (size_t)row * D + 8 * lane + 512 * j) = pack8(xv[q][j]);
#pragma unroll
                    for (int e = 0; e < 8; ++e) ss += xv[q][j][e] * xv[q][j][e]; }
                const float rstd = 1.0f / sqrtf(wave_sum(ss) * (1.0f / D) + RMS_EPS);
#pragma unroll
                for (int j = 0; j < 4; ++j) { const f32x4 ga = *(const f32x4*)(gB + 8 * lane + 512 * j), gb = *(const f32x4*)(gB + 8 * lane + 512 * j + 4);
                    const float g8[8] = {ga[0], ga[1], ga[2], ga[3], gb[0], gb[1], gb[2], gb[3]}; float o[8];
#pragma unroll
                    for (int e = 0; e < 8; ++e) o[e] = xv[q][j][e] * rstd * g8[e];
                    *(u32x4*)(h + (size_t)row * D + 8 * lane + 512 * j) = pack8(o); }
            } } }
    }
}

__device__ __forceinline__ void memnorm_phase(const float* mem_p, const float* mem_s, const float* g, bf16_t* memn, int gw, int NGW, int lane) {
    for (int row = gw; row < NMEMTOK; row += NGW) {
        const float* src = row < 1024 ? mem_p + (size_t)row * D : mem_s + (size_t)(row - 1024) * D;
        float xv[4][8]; float ss = 0.f;
#pragma unroll
        for (int j = 0; j < 4; ++j) { const f32x4 a = *(const f32x4*)(src + 8 * lane + 512 * j), b = *(const f32x4*)(src + 8 * lane + 512 * j + 4);
            xv[j][0] = a[0]; xv[j][1] = a[1]; xv[j][2] = a[2]; xv[j][3] = a[3]; xv[j][4] = b[0]; xv[j][5] = b[1]; xv[j][6] = b[2]; xv[j][7] = b[3];
#pragma unroll
            for (int e = 0; e < 8; ++e) ss += xv[j][e] * xv[j][e]; }
        const float rstd = 1.0f / sqrtf(wave_sum(ss) * (1.0f / D) + RMS_EPS);
#pragma unroll
        for (int j = 0; j < 4; ++j) { const f32x4 ga = *(const f32x4*)(g + 8 * lane + 512 * j), gb = *(const f32x4*)(g + 8 * lane + 512 * j + 4);
            u32x4 w; w.x = pk2(xv[j][0] * rstd * ga[0], xv[j][1] * rstd * ga[1]); w.y = pk2(xv[j][2] * rstd * ga[2], xv[j][3] * rstd * ga[3]);
            w.z = pk2(xv[j][4] * rstd * gb[0], xv[j][5] * rstd * gb[1]); w.w = pk2(xv[j][6] * rstd * gb[2], xv[j][7] * rstd * gb[3]);
            *(u32x4*)(memn + (size_t)row * D + 8 * lane + 512 * j) = w; }
    }
}

__device__ __forceinline__ void softmax_phase(const float* S, bf16_t* P, int gw, int NGW, int lane) {
    for (int row0 = gw; row0 < NT; row0 += 2 * NGW) {
        f32x4 v[2][4];
#pragma unroll
        for (int q = 0; q < 2; ++q) { const int row = row0 + q * NGW; if (row < NT) {
#pragma unroll
            for (int hd = 0; hd < 4; ++hd) v[q][hd] = *(const f32x4*)(S + (size_t)row * 1024 + hd * 256 + 4 * lane); } }
#pragma unroll
        for (int q = 0; q < 2; ++q) { const int row = row0 + q * NGW; if (row < NT) {
#pragma unroll
            for (int hd = 0; hd < 4; ++hd) { const f32x4 x = v[q][hd];
                const float mx = wave_max(fmaxf(fmaxf(x[0], x[1]), fmaxf(x[2], x[3])));
                const float e0 = __expf(x[0] - mx), e1 = __expf(x[1] - mx), e2 = __expf(x[2] - mx), e3 = __expf(x[3] - mx);
                const float inv = 1.0f / wave_sum((e0 + e1) + (e2 + e3));
                u32x2 w; w.x = pk2(e0 * inv, e1 * inv); w.y = pk2(e2 * inv, e3 * inv);
                *(u32x2*)(P + (size_t)row * 1024 + hd * 256 + 4 * lane) = w; } } }
    }
}

__device__ __forceinline__ void tables_phase(f32x2* TW, float* rc, float* rs, int gtid, int NGT) {
    for (int k = gtid; k < 8192; k += NGT) { const float a = (float)k * (1.0f / 8192.0f); TW[k] = MK2(cospif(a), -sinpif(a)); }
    for (int idx = gtid; idx < 8192 * 128; idx += NGT) { const int pos = idx >> 7, i = idx & 127;
        const double inv = pow(10000.0, -(double)i / 128.0), ang = (double)pos * inv; rc[idx] = (float)cos(ang); rs[idx] = (float)sin(ang); }
}

__device__ __forceinline__ void hyena_hid_phase(const float* w1, const float* b1, const float* freq, const float* w2, const float* b2, bf16_t* hid2, int gw, int NGW, int lane) {
    for (int t = gw; t < 8192 + 4096; t += NGW) {
        const int L = t < 8192 ? 8192 : 4096, l = t < 8192 ? t : t - 8192;
        const double tn = (double)l / (double)L;
        float feat = 0.f;
        if (lane == 0) feat = (float)tn;
        else if (lane <= 16) feat = (float)cos(6.283185307179586476925 * tn * (double)lane);
        else if (lane <= 32) feat = (float)sin(6.283185307179586476925 * tn * (double)(lane - 16));
        float a = b1[lane];
        for (int e = 0; e < 33; ++e) a += __shfl(feat, e) * w1[e * 64 + lane];
        const float h1 = sinf(freq[lane] * a);
        float c = b2[lane];
        for (int i = 0; i < 64; ++i) c += __shfl(h1, i) * w2[i * 64 + lane];
        hid2[(size_t)t * 64 + lane] = (bf16_t)f2bf(sinf(freq[64 + lane] * c));
    }
}

__device__ __forceinline__ void s5_tables_phase(const float* a_re, const float* a_im, const float* log_dt, const float* b_re, const float* b_im, const float* c_re, const float* c_im, f32x2* lamb, bf16_t* bua, bf16_t* cmb, int gtid, int NGT) {
    for (int idx = gtid; idx < 64 * 4 * 64; idx += NGT) { const int lane = idx & 63, s = (idx >> 6) & 3, dg = idx >> 8, i = lane & 15, kq = lane >> 4; unsigned w[4];
#pragma unroll
        for (int j2 = 0; j2 < 4; ++j2) { float v[2];
#pragma unroll
            for (int e = 0; e < 2; ++e) { const int k = 32 * s + 8 * kq + 2 * j2 + e; v[e] = (k < 64) ? c_re[((size_t)dg * 16 + i) * 64 + k] : -c_im[((size_t)dg * 16 + i) * 64 + (k - 64)]; }
            w[j2] = f2bf(v[0]) | (f2bf(v[1]) << 16); }
        *(u32x4*)(cmb + (size_t)idx * 8) = (u32x4){w[0], w[1], w[2], w[3]}; }
    for (int idx = gtid; idx < 64 * 8 * 64; idx += NGT) { const int lane = idx & 63, ti = (idx >> 6) & 7, dg = idx >> 9, comp = 16 * ti + (lane & 15), p = comp >> 1, part = comp & 1, kq = lane >> 4, sidx = dg * 64 + p;
        const double ar = a_re[sidx], ai = a_im[sidx], dt = exp((double)log_dt[dg]);
        const double er = exp(ar * dt), lr = er * cos(ai * dt), li = er * sin(ai * dt);
        const double nr = lr - 1.0, ni = li, den = ar * ar + ai * ai;
        const double cr = (nr * ar + ni * ai) / den, ci = (ni * ar - nr * ai) / den;
        if (part == 0 && kq == 0) lamb[sidx] = MK2((float)lr, (float)li);
        unsigned w[4];
#pragma unroll
        for (int j2 = 0; j2 < 4; ++j2) { float v[2];
#pragma unroll
            for (int e = 0; e < 2; ++e) { const int ch = 8 * kq + 2 * j2 + e; float val = 0.f;
                if (kq < 2) { const double br = b_re[(size_t)sidx * 16 + ch], bi = b_im[(size_t)sidx * 16 + ch]; val = part ? (float)(cr * bi + ci * br) : (float)(cr * br - ci * bi); }
                v[e] = val; }
            w[j2] = f2bf(v[0]) | (f2bf(v[1]) << 16); }
        *(u32x4*)(bua + (size_t)idx * 8) = (u32x4){w[0], w[1], w[2], w[3]}; }
}

__device__ __forceinline__ int PD(int i) { return i + (i >> 4); }
__device__ __forceinline__ f32x2 cmul(f32x2 a, f32x2 b) { f32x2 t, d;
    asm("v_pk_mul_f32 %0, %1, %2 op_sel:[0,0] op_sel_hi:[0,1]" : "=v"(t) : "v"(a), "v"(b));
    asm("v_pk_fma_f32 %0, %1, %2, %3 op_sel:[1,1,0] op_sel_hi:[1,0,1] neg_lo:[0,1,0]" : "=v"(d) : "v"(a), "v"(b), "v"(t));
    return d; }
__device__ __forceinline__ f32x2 cmulc(f32x2 a, f32x2 b) { f32x2 t, d;
    asm("v_pk_mul_f32 %0, %1, %2 op_sel:[0,0] op_sel_hi:[0,1]" : "=v"(t) : "v"(a), "v"(b));
    asm("v_pk_fma_f32 %0, %1, %2, %3 op_sel:[1,1,0] op_sel_hi:[1,0,1] neg_hi:[0,0,1]" : "=v"(d) : "v"(a), "v"(b), "v"(t));
    return d; }

template <int LOGN, int A, int R, int INV, int PRUNE = 0>
__device__ __forceinline__ void fft_pass(LAS f32x2* x, const f32x2* TW, int tid) {
    asm volatile("" : "+v"(tid));
    constexpr int N = 1 << LOGN, RAD = 1 << R, LOGSB = A - R + 1, SB = 1 << LOGSB;
    constexpr float C16[16] = {1.0f, 0.98078528040323043f, 0.92387953251128674f, 0.83146961230254524f, 0.70710678118654752f, 0.55557023301960218f, 0.38268343236508977f, 0.19509032201612825f,
                               0.0f, -0.19509032201612825f, -0.38268343236508977f, -0.55557023301960218f, -0.70710678118654752f, -0.83146961230254524f, -0.92387953251128674f, -0.98078528040323043f};
    constexpr float S16[16] = {0.0f, -0.19509032201612825f, -0.38268343236508977f, -0.55557023301960218f, -0.70710678118654752f, -0.83146961230254524f, -0.92387953251128674f, -0.98078528040323043f,
                               -1.0f, -0.98078528040323043f, -0.92387953251128674f, -0.83146961230254524f, -0.70710678118654752f, -0.55557023301960218f, -0.38268343236508977f, -0.19509032201612825f};
#pragma unroll 1
    for (int g = tid; g < N / RAD; g += NWG_THREADS) {
        const int lo = g & (SB - 1), hi = g >> LOGSB;
        const int base = (hi << (A + 1)) | lo;
        static_assert(SB % 16 == 0 || (SB == 1 && RAD <= 16), "padded-index offsets"); static_assert(RAD <= 32, "twiddle table");
        constexpr int PDS = (SB >= 16) ? SB + SB / 16 : SB; const int pdb = PD(base);
        f32x2 e[RAD];
#pragma unroll
        for (int j = 0; j < RAD; ++j) { if (PRUNE && !INV && j >= RAD / 2) e[j] = MK2(0.f, 0.f); else e[j] = x[pdb + j * PDS]; }
#pragma unroll
        for (int qq = 0; qq < R; ++qq) {
            const int q = INV ? (R - 1 - qq) : qq;
            const int half = RAD >> (q + 1);
            const float rev_ = (float)(lo << (LOGN - 1 - A + q)) * (1.0f / (float)N);
            f32x2 wq = MK2(__builtin_amdgcn_cosf(rev_), -__builtin_amdgcn_sinf(rev_));
            asm("s_nop 1" : "+v"(wq));
#pragma unroll
            for (int j = 0; j < RAD; ++j) {
                if (j & half) continue;
                const int m16 = ((j & (half - 1)) * 16) / half;
                const f32x2 w = (m16 == 0) ? wq : cmul(wq, MK2(C16[m16], S16[m16]));
                if (!INV) { if (PRUNE && q == 0) { e[j + half] = cmul(e[j], w); } else { const f32x2 a = e[j], b = e[j + half]; e[j] = a + b; e[j + half] = cmul(a - b, w); } }
                else { const f32x2 a = e[j], b = cmulc(e[j + half], w); e[j] = a + b; e[j + half] = a - b; }
            }
        }
#pragma unroll
        for (int j = 0; j < RAD; ++j) { if (PRUNE && INV && j >= RAD / 2) continue; x[pdb + j * PDS] = e[j]; }
    }
    __syncthreads();
}
template <int LOGN, int PRUNE = 0> __device__ __forceinline__ void fft_fwd(LAS f32x2* x, const f32x2* TW, int tid) {
    if constexpr (LOGN == 14) { fft_pass<LOGN, 13, 5, 0, PRUNE>(x, TW, tid); fft_pass<LOGN, 8, 5, 0>(x, TW, tid); fft_pass<LOGN, 3, 4, 0>(x, TW, tid); }
    else { static_assert(LOGN == 13, "pass plan"); fft_pass<LOGN, 12, 5, 0, PRUNE>(x, TW, tid); fft_pass<LOGN, 7, 4, 0>(x, TW, tid); fft_pass<LOGN, 3, 4, 0>(x, TW, tid); }
}
template <int LOGN, int PRUNE = 0> __device__ __forceinline__ void fft_inv(LAS f32x2* x, const f32x2* TW, int tid) {
    if constexpr (LOGN == 14) { fft_pass<LOGN, 3, 4, 1>(x, TW, tid); fft_pass<LOGN, 8, 5, 1>(x, TW, tid); fft_pass<LOGN, 13, 5, 1, PRUNE>(x, TW, tid); }
    else { fft_pass<LOGN, 3, 4, 1>(x, TW, tid); fft_pass<LOGN, 7, 4, 1>(x, TW, tid); fft_pass<LOGN, 12, 5, 1, PRUNE>(x, TW, tid); }
}
template <int LOGN> __device__ __forceinline__ int brev(int p) { return (int)(__brev((unsigned)p) >> (32 - LOGN)); }

constexpr int SPEC_STRIDE = 8200;

template <int LOGN>
__device__ __forceinline__ void hy_pointwise(LAS f32x2* x, const f32x4* spec, int tid) {
    asm volatile("" : "+v"(tid));
    constexpr int N = 1 << LOGN;
#pragma unroll 4
    for (int m = tid; m < N / 2; m += NWG_THREADS) {
        const int p = 2 * m, k = brev<LOGN>(p), pm = brev<LOGN>((N - k) & (N - 1));
        const f32x2 Zk = x[PD(p)], Zm = x[PD(pm)]; const f32x4 H = spec[m];
        const f32x2 A2 = MK2(Zk.x + Zm.x, Zk.y - Zm.y), B2 = MK2(Zk.x - Zm.x, Zk.y + Zm.y);
        const f32x2 P = cmul(A2, MK2(H.x, H.y)), W = cmul(B2, MK2(H.z, H.w));
        x[PD(p)] = MK2(P.x + W.x, P.y + W.y);
        if (pm != p) x[PD(pm)] = MK2(P.x - W.x, W.y - P.y);
    }
    if (tid == 0) { const f32x2 Z = x[PD(1)]; const f32x4 H = spec[N / 2]; x[PD(1)] = MK2(Z.x * H.x, Z.y * H.z); }
    __syncthreads();
}

struct HyArgs {
    const bf16_t* pT;
    const float* short_w;
    const float* short_b;
    const bf16_t* hid2;
    const float* w3;
    const float* skip;
    const f32x2* TW;
    bf16_t* z2;
};
typedef __amdgpu_buffer_rsrc_t rsrc_t;
__device__ __forceinline__ rsrc_t hy_rsrc(const bf16_t* prow, int L) { return __builtin_amdgcn_make_buffer_rsrc((void*)prow, 0, L * 2, 0x00020000); }
__device__ __forceinline__ void hy_sc8(rsrc_t r, int l0, const float* short_w, const float* short_b, int row, float (&o)[8]) {
    asm volatile("" : "+s"(row));
    const float sw[4] = {short_w[row], short_w[4608 + row], short_w[2 * 4608 + row], short_b[row]};
    const int bo = l0 * 2;
    const u32x4 c = __builtin_bit_cast(u32x4, __builtin_amdgcn_raw_buffer_load_b128(r, bo, 0, 0));
    float v[10];
    v[1] = bf_lo(c.x); v[2] = bf_hi(c.x); v[3] = bf_lo(c.y); v[4] = bf_hi(c.y); v[5] = bf_lo(c.z); v[6] = bf_hi(c.z); v[7] = bf_lo(c.w); v[8] = bf_hi(c.w);
    v[0] = bf1((bf16_t)__builtin_amdgcn_raw_buffer_load_b16(r, bo - 2, 0, 0)); v[9] = bf1((bf16_t)__builtin_amdgcn_raw_buffer_load_b16(r, bo + 16, 0, 0));
#pragma unroll
    for (int e = 0; e < 8; ++e) o[e] = sw[0] * v[e] + sw[1] * v[e + 1] + sw[2] * v[e + 2] + sw[3];
}

template <int LOGN>
__device__ __forceinline__ void hyena_task(LAS unsigned char* lds, const HyArgs& H, int ch, int tokbase, int nbatch, f32x4* spec, int tid) {
    constexpr int N = 1 << LOGN, L = N / 2;
    asm volatile("" : "+v"(tid));
    LAS f32x2* x = (LAS f32x2*)lds;
    LAS f32x4* w3s = (LAS f32x4*)(lds + 139264);
    const bf16_t* hid = H.hid2 + (LOGN == 14 ? 0 : (size_t)8192 * 64);
    const float la = -3.0701134573253944f, lb = -15.350567286626972f;
    const float dela = fabsf(la + (lb - la) * ((float)ch / 1535.0f)), delb = fabsf(la + (lb - la) * ((float)(ch + 1) / 1535.0f));
    for (int o = 0; o < 2; ++o) {
        if (tid < 256) { const int j = tid >> 2, q = tid & 3; ((LAS float*)w3s)[tid] = H.w3[(size_t)j * 6144 + (o * 2 + (q >> 1)) * 1536 + ch + (q & 1)]; }
        __syncthreads();
        { const int lane = tid & 63, wave = __builtin_amdgcn_readfirstlane(tid >> 6), n = lane & 15, kq = lane >> 4;
          bf16x8 Wf[2];
#pragma unroll
          for (int kb = 0; kb < 2; ++kb) { u32x4 w = (u32x4){0u, 0u, 0u, 0u};
              if (n < 4) { float f[8];
#pragma unroll
                  for (int i = 0; i < 8; ++i) f[i] = ((const LAS float*)w3s)[(32 * kb + 8 * kq + i) * 4 + n];
                  w.x = pk2(f[0], f[1]); w.y = pk2(f[2], f[3]); w.z = pk2(f[4], f[5]); w.w = pk2(f[6], f[7]); }
              Wf[kb] = __builtin_bit_cast(bf16x8, w); }
#pragma unroll 4
          for (int lt = wave; lt < L / 16; lt += 8) {
              const int l = lt * 16 + n;
              const bf16x8 h0 = *(const bf16x8*)(hid + (size_t)l * 64 + 8 * kq), h1 = *(const bf16x8*)(hid + (size_t)l * 64 + 32 + 8 * kq);
              f32x4 acc = __builtin_amdgcn_mfma_f32_16x16x32_bf16(Wf[0], h0, (f32x4){0.f, 0.f, 0.f, 0.f}, 0, 0, 0);
              acc = __builtin_amdgcn_mfma_f32_16x16x32_bf16(Wf[1], h1, acc, 0, 0, 0);
              if (kq == 0) {
                  const float tn = (float)l / (float)L; const float da = expf(-tn * dela), db = expf(-tn * delb);
                  x[PD(l)] = MK2(acc[0] * da, acc[1] * db);
                  if (l >= 1) x[PD(N - l)] = MK2(acc[2] * da, acc[3] * db);
                  if (l == 0) x[PD(L)] = MK2(0.f, 0.f); }
          } }
        __syncthreads();
        fft_fwd<LOGN>(x, H.TW, tid);
        f32x4* so = spec + (size_t)o * SPEC_STRIDE;
        const float sc = 1.0f / (4.0f * (float)N);
#pragma unroll 2
        for (int m = tid; m < N / 2; m += NWG_THREADS) {
            const int p = 2 * m, k = brev<LOGN>(p), pm = brev<LOGN>((N - k) & (N - 1));
            const f32x2 Gk = x[PD(p)], Gm = x[PD(pm)];
            so[m] = MK4((Gk.x + Gm.x) * sc, (Gk.y - Gm.y) * sc, (Gk.y + Gm.y) * sc, -(Gk.x - Gm.x) * sc);
        }
        if (tid == 0) { const f32x2 G = x[PD(1)]; so[N / 2] = MK4(G.x / (float)N, 0.f, G.y / (float)N, 0.f); }
        VM_WAIT(); __syncthreads();
    }
    constexpr int NG = L / 8 / NWG_THREADS;
    for (int b = 0; b < nbatch; ++b) {
        asm volatile("" : "+v"(tid));
        const size_t tok0 = (size_t)tokbase + (size_t)b * L;
        const rsrc_t rv_a = hy_rsrc(H.pT + (size_t)ch * NT + tok0, L), rv_b = hy_rsrc(H.pT + (size_t)(ch + 1) * NT + tok0, L);
        const rsrc_t r1_a = hy_rsrc(H.pT + (size_t)(1536 + ch) * NT + tok0, L), r1_b = hy_rsrc(H.pT + (size_t)(1536 + ch + 1) * NT + tok0, L);
        const rsrc_t rz_a = hy_rsrc(H.z2 + (size_t)ch * NT + tok0, L), rz_b = hy_rsrc(H.z2 + (size_t)(ch + 1) * NT + tok0, L);
        const rsrc_t r2_a = hy_rsrc(H.pT + (size_t)(3072 + ch) * NT + tok0, L), r2_b = hy_rsrc(H.pT + (size_t)(3072 + ch + 1) * NT + tok0, L);
#pragma unroll
        for (int i = 0; i < NG; ++i) { const int l0 = 8 * (tid + NWG_THREADS * i); float va[8], vb[8];
            hy_sc8(rv_a, l0, H.short_w, H.short_b, ch, va); hy_sc8(rv_b, l0, H.short_w, H.short_b, ch + 1, vb);
#pragma unroll
            for (int e = 0; e < 8; ++e) { x[PD(l0 + e)] = MK2(va[e], vb[e]); } }
        __syncthreads();
        fft_fwd<LOGN, 1>(x, H.TW, tid);
        hy_pointwise<LOGN>(x, spec, tid);
        fft_inv<LOGN, 1>(x, H.TW, tid);
        f32x4* z1s = spec + 2 * SPEC_STRIDE;
#pragma unroll
        for (int i = 0; i < NG; ++i) { const int l0 = 8 * (tid + NWG_THREADS * i); float va[8], vb[8], xa[8], xb[8], za[8], zb[8];
            hy_sc8(rv_a, l0, H.short_w, H.short_b, ch, va); hy_sc8(rv_b, l0, H.short_w, H.short_b, ch + 1, vb); hy_sc8(r1_a, l0, H.short_w, H.short_b, 1536 + ch, xa); hy_sc8(r1_b, l0, H.short_w, H.short_b, 1536 + ch + 1, xb);
            const float sk0a = H.skip[ch], sk0b = H.skip[ch + 1];
#pragma unroll
            for (int e = 0; e < 8; ++e) { const f32x2 y = x[PD(l0 + e)]; za[e] = xa[e] * (y.x + sk0a * va[e]); zb[e] = xb[e] * (y.y + sk0b * vb[e]); }
            f32x4* zp = z1s + (size_t)(i * NWG_THREADS + tid) * 4;
            zp[0] = MK4(za[0], za[1], za[2], za[3]); zp[1] = MK4(za[4], za[5], za[6], za[7]); zp[2] = MK4(zb[0], zb[1], zb[2], zb[3]); zp[3] = MK4(zb[4], zb[5], zb[6], zb[7]);
            __syncthreads();
#pragma unroll
            for (int e = 0; e < 8; ++e) { x[PD(l0 + e)] = MK2(za[e], zb[e]); } }
        __syncthreads();
        fft_fwd<LOGN, 1>(x, H.TW, tid);
        hy_pointwise<LOGN>(x, spec + SPEC_STRIDE, tid);
        fft_inv<LOGN, 1>(x, H.TW, tid);
#pragma unroll
        for (int i = 0; i < NG; ++i) { const int l0 = 8 * (tid + NWG_THREADS * i); float xa[8], xb[8], oa[8], ob[8];
            hy_sc8(r2_a, l0, H.short_w, H.short_b, 3072 + ch, xa); hy_sc8(r2_b, l0, H.short_w, H.short_b, 3072 + ch + 1, xb);
            const f32x4* zp = z1s + (size_t)(i * NWG_THREADS + tid) * 4; const f32x4 q0 = zp[0], q1 = zp[1], q2 = zp[2], q3 = zp[3];
            const float za[8] = {q0[0], q0[1], q0[2], q0[3], q1[0], q1[1], q1[2], q1[3]}, zb[8] = {q2[0], q2[1], q2[2], q2[3], q3[0], q3[1], q3[2], q3[3]};
            const float sk1a = H.skip[1536 + ch], sk1b = H.skip[1536 + ch + 1];
#pragma unroll
            for (int e = 0; e < 8; ++e) { const f32x2 y = x[PD(l0 + e)]; oa[e] = xa[e] * (y.x + sk1a * za[e]); ob[e] = xb[e] * (y.y + sk1b * zb[e]); }
            u32x4 wa, wb; wa.x = pk2(oa[0], oa[1]); wa.y = pk2(oa[2], oa[3]); wa.z = pk2(oa[4], oa[5]); wa.w = pk2(oa[6], oa[7]);
            wb.x = pk2(ob[0], ob[1]); wb.y = pk2(ob[2], ob[3]); wb.z = pk2(ob[4], ob[5]); wb.w = pk2(ob[6], ob[7]);
            __builtin_amdgcn_raw_buffer_store_b128(__builtin_bit_cast(__attribute__((__vector_size__(4 * sizeof(unsigned)))) unsigned, wa), rz_a, l0 * 2, 0, 0);
            __builtin_amdgcn_raw_buffer_store_b128(__builtin_bit_cast(__attribute__((__vector_size__(4 * sizeof(unsigned)))) unsigned, wb), rz_b, l0 * 2, 0, 0); }
        __syncthreads();
    }
}

constexpr int HN_RED = 104 * 1024, HN_RED2 = HN_RED + 16384, HN_RSTD = HN_RED2 + 2048;
__device__ __forceinline__ int hn_row(int c) { return (c + (c >> 5)) * 64; }
__device__ __forceinline__ void hyena_norm_phase(LAS unsigned char* lds, const bf16_t* pT, const float* out_g, bf16_t* mixo, int wg, int nwg, int tid) {
    LAS unsigned char* tile = lds; LAS float* red = (LAS float*)(lds + HN_RED); LAS float* red2 = (LAS float*)(lds + HN_RED2); LAS float* rstd = (LAS float*)(lds + HN_RSTD);
    const int lane = tid & 63, wave = tid >> 6, cl = tid >> 2, tg = tid & 3;
    const int pos = (nwg == 256) ? ((((wg >> 4) * 8 + (wg & 7)) << 1) | ((wg >> 3) & 1)) : wg;
    constexpr int NTILE = NT / 32;
    u32x4 v[12];
    float gv[12];
#pragma unroll
    for (int it = 0; it < 12; ++it) gv[it] = out_g[it * 128 + cl];
    int tt = pos;
    if (tt < NTILE) {
#pragma unroll
        for (int it = 0; it < 12; ++it) v[it] = *(const u32x4*)(pT + (size_t)(it * 128 + cl) * NT + tt * 32 + tg * 8); }
    for (; tt < NTILE; tt += nwg) {
        const int t0 = tt * 32;
        float ss[8] = {0.f, 0.f, 0.f, 0.f, 0.f, 0.f, 0.f, 0.f};
#pragma unroll
        for (int it = 0; it < 12; ++it) { const u32x4 q = v[it]; float f;
            f = bf_lo(q.x); ss[0] += f * f; f = bf_hi(q.x); ss[1] += f * f; f = bf_lo(q.y); ss[2] += f * f; f = bf_hi(q.y); ss[3] += f * f;
            f = bf_lo(q.z); ss[4] += f * f; f = bf_hi(q.z); ss[5] += f * f; f = bf_lo(q.w); ss[6] += f * f; f = bf_hi(q.w); ss[7] += f * f; }
        *(LAS f32x4*)(red + cl * 32 + tg * 8) = MK4(ss[0], ss[1], ss[2], ss[3]); *(LAS f32x4*)(red + cl * 32 + tg * 8 + 4) = MK4(ss[4], ss[5], ss[6], ss[7]);
        __syncthreads();
        { const int tk = tid & 31, part = tid >> 5; float s = 0.f;
#pragma unroll
          for (int r = 0; r < 8; ++r) s += red[(part * 8 + r) * 32 + tk];
          red2[part * 32 + tk] = s; }
        __syncthreads();
        if (tid < 32) { float s = 0.f;
#pragma unroll
            for (int p = 0; p < 16; ++p) s += red2[p * 32 + tid];
            rstd[tid] = 1.0f / sqrtf(s * (1.0f / HYW) + RMS_EPS); }
        __syncthreads();
        { const f32x4 r0 = *(const LAS f32x4*)(rstd + tg * 8), r1 = *(const LAS f32x4*)(rstd + tg * 8 + 4);
#pragma unroll
          for (int it = 0; it < 12; ++it) { const int c = it * 128 + cl; const float g = gv[it]; const u32x4 q = v[it]; u32x4 w;
              w.x = pk2(bf_lo(q.x) * r0[0] * g, bf_hi(q.x) * r0[1] * g); w.y = pk2(bf_lo(q.y) * r0[2] * g, bf_hi(q.y) * r0[3] * g);
              w.z = pk2(bf_lo(q.z) * r1[0] * g, bf_hi(q.z) * r1[1] * g); w.w = pk2(bf_lo(q.w) * r1[2] * g, bf_hi(q.w) * r1[3] * g);
              *(LAS u32x4*)(tile + hn_row(c) + ((tg ^ ((c >> 3) & 3)) << 4)) = w; } }
        __syncthreads();
        if (tt + nwg < NTILE) {
#pragma unroll
            for (int it = 0; it < 12; ++it) v[it] = *(const u32x4*)(pT + (size_t)(it * 128 + cl) * NT + (tt + nwg) * 32 + tg * 8); }
#pragma unroll
        for (int k = 0; k < 6; ++k) { const int combo = wave + 8 * k, tp = 4 * (combo & 3) + (lane & 3), cg = (combo >> 2) * 16 + (lane >> 2);
            unsigned d[8];
#pragma unroll
            for (int e = 0; e < 8; ++e) { const int c = 8 * cg + e; d[e] = *(const LAS unsigned*)(tile + hn_row(c) + ((((tp >> 2) ^ (cg & 3))) << 4) + (tp & 3) * 4); }
            u32x4 wl, wh;
            wl.x = (d[0] & 0xffffu) | (d[1] << 16); wl.y = (d[2] & 0xffffu) | (d[3] << 16); wl.z = (d[4] & 0xffffu) | (d[5] << 16); wl.w = (d[6] & 0xffffu) | (d[7] << 16);
            wh.x = (d[0] >> 16) | (d[1] & 0xffff0000u); wh.y = (d[2] >> 16) | (d[3] & 0xffff0000u); wh.z = (d[4] >> 16) | (d[5] & 0xffff0000u); wh.w = (d[6] >> 16) | (d[7] & 0xffff0000u);
            *(u32x4*)(mixo + (size_t)(t0 + 2 * tp) * D + 8 * cg) = wl; *(u32x4*)(mixo + (size_t)(t0 + 2 * tp + 1) * D + 8 * cg) = wh; }
    }
}

struct S5Args {
    const bf16_t* u5;
    const f32x2* lamb;
    const bf16_t* bua;
    const bf16_t* cmb;
    const float* dvec;
    f32x2* st;
    bf16_t* ssg;
};
__device__ __forceinline__ void s5_chunk_info(int cidx, int& c, int& nc, int& c0) {
    if (cidx < 256) { c = cidx & 63; nc = 64; c0 = cidx & ~63; } else { const int cc = cidx - 256; c = cc & 31; nc = 32; c0 = 256 + (cc & ~31); }
}
constexpr int S5_UP = 144;
constexpr int S5_UB = 0, S5_YB = 128 * S5_UP  , S5_SB = S5_YB + 65536  , S5_BB = S5_SB + 8 * 16 * 272  ;
template <int PASS>
__device__ __forceinline__ void s5_phase(LAS unsigned char* lds, const S5Args& A, int wg, int nwg, int tid) {
    LAS unsigned char* UB = lds + S5_UB; LAS float* yb = (LAS float*)(lds + S5_YB);
    const int lane = tid & 63, wave = __builtin_amdgcn_readfirstlane(tid >> 6), gl = wave & 3, dir = wave >> 2;
    LAS unsigned char* SBw = lds + S5_SB + wave * (16 * 272);
    LAS unsigned char* BBw = lds + S5_BB + wave * (16 * 256);
    const bool gbconst = (nwg & 7) == 0;
    const int n16 = lane & 15, kq = lane >> 4;
    f32x2 lam = MK2(0.f, 0.f); bf16x8 BfT[8], CfT[4];
    u32x4 pa[2];
#define S5_PREF(t_) do { const int gb_ = (t_) & 7, tt_ = ((t_) >> 3) * 128; _Pragma("unroll") for (int i = 0; i < 2; ++i) { const int id = tid + NWG_THREADS * i, row = id >> 3, c = id & 7; \
        pa[i] = *(const u32x4*)(A.u5 + (size_t)(tt_ + row) * 512 + gb_ * 64 + c * 8); } } while (0)
    if (wg < 320 * 8) S5_PREF(wg);
    for (int task = wg; task < 320 * 8; task += nwg) {
        const int gb = task & 7, cidx = task >> 3, t0 = cidx * 128, g = gb * 4 + gl, dg = dir * 32 + g;
        __syncthreads();
#pragma unroll
        for (int i = 0; i < 2; ++i) { const int id = tid + NWG_THREADS * i, row = id >> 3, c = id & 7; *(LAS u32x4*)(UB + row * S5_UP + c * 16) = pa[i]; }
        __syncthreads();
        if (task == wg || !gbconst) {
            lam = A.lamb[dg * 64 + lane];
#pragma unroll
            for (int ti = 0; ti < 8; ++ti) BfT[ti] = *(const bf16x8*)(A.bua + ((size_t)(dg * 8 + ti) * 64 + lane) * 8);
            if (PASS == 1) {
#pragma unroll
                for (int s = 0; s < 4; ++s) CfT[s] = *(const bf16x8*)(A.cmb + ((size_t)(dg * 4 + s) * 64 + lane) * 8); }
        }
        float sr = 0.f, si = 0.f;
        if (PASS == 1) {
            f32x2 lt = lam;
#pragma unroll
            for (int q = 0; q < 7; ++q) lt = MK2(lt.x * lt.x - lt.y * lt.y, 2.0f * lt.x * lt.y);
            int c, nc, c0; s5_chunk_info(cidx, c, nc, c0);
            const int nterm = dir ? (nc - 1 - c) : c;
            for (int j0 = 0; j0 < nterm; j0 += 16) { f32x2 e[16];
#pragma unroll
                for (int k = 0; k < 16; ++k) { const int j = j0 + k; const int cj = dir ? (nc - 1 - j) : j;
                    e[k] = (j < nterm) ? A.st[((size_t)(c0 + cj) * 2 + dir) * 2048 + g * 64 + lane] : MK2(0.f, 0.f); }
#pragma unroll
                for (int k = 0; k < 16; ++k) if (j0 + k < nterm) { const float nr = lt.x * sr - lt.y * si + e[k].x, ni = lt.x * si + lt.y * sr + e[k].y; sr = nr; si = ni; } }
        }
        if (task + nwg < 320 * 8) S5_PREF(task + nwg);
#pragma unroll 1
        for (int blk = 0; blk < 8; ++blk) {
            { const int tb = dir ? (127 - (16 * blk + n16)) : (16 * blk + n16);
              u32x4 ub = (u32x4){0u, 0u, 0u, 0u};
              if (kq < 2) ub = *(const LAS u32x4*)(UB + tb * S5_UP + gl * 32 + kq * 16);
              const bf16x8 Uf = __builtin_bit_cast(bf16x8, ub);
              f32x4 zz[8];
#pragma unroll
              for (int ti = 0; ti < 8; ++ti) {
                  zz[ti] = __builtin_amdgcn_mfma_f32_16x16x32_bf16(BfT[ti], Uf, (f32x4){0.f, 0.f, 0.f, 0.f}, 0, 0, 0); }
              asm volatile("s_nop 15" : "+v"(zz[0]), "+v"(zz[1]), "+v"(zz[2]), "+v"(zz[3]));
              asm volatile("s_nop 15" : "+v"(zz[4]), "+v"(zz[5]), "+v"(zz[6]), "+v"(zz[7]));
#pragma unroll
              for (int ti = 0; ti < 8; ++ti) { u32x2 w; w.x = pk2(zz[ti][0], zz[ti][1]); w.y = pk2(zz[ti][2], zz[ti][3]);
                  *(LAS u32x2*)(BBw + n16 * 256 + (8 * ti + 2 * kq) * 4) = w; }
              asm volatile("s_waitcnt lgkmcnt(0)" ::: "memory"); }
#pragma unroll
            for (int j = 0; j < 16; ++j) {
                const unsigned bw = *(const LAS unsigned*)(BBw + j * 256 + lane * 4);
                const float xr = bf_lo(bw), xi = bf_hi(bw);
                const float nr = lam.x * sr - lam.y * si + xr, ni = lam.x * si + lam.y * sr + xi; sr = nr; si = ni;
                if (PASS == 1) { *(LAS bf16_t*)(SBw + j * 272 + lane * 2) = (bf16_t)f2bf(sr); *(LAS bf16_t*)(SBw + j * 272 + 128 + lane * 2) = (bf16_t)f2bf(si); }
            }
            if (PASS == 1) {
                asm volatile("s_waitcnt lgkmcnt(0)" ::: "memory");
                f32x4 ya = (f32x4){0.f, 0.f, 0.f, 0.f};
#pragma unroll
                for (int s = 0; s < 4; ++s) { const bf16x8 Sf = *(const LAS bf16x8*)(SBw + n16 * 272 + 64 * s + 16 * kq);
                    ya = __builtin_amdgcn_mfma_f32_16x16x32_bf16(Sf, CfT[s], ya, 0, 0, 0); }
#pragma unroll
                for (int r = 0; r < 4; ++r) { const int tt = 16 * blk + 4 * kq + r, t = dir ? (127 - tt) : tt;
                    yb[(dir * 128 + t) * 64 + gl * 16 + n16] = ya[r]; }
            }
            asm volatile("s_waitcnt lgkmcnt(0)" ::: "memory");
        }
        if (PASS == 0) { A.st[((size_t)cidx * 2 + dir) * 2048 + g * 64 + lane] = MK2(sr, si); }
        else {
            __syncthreads();
#pragma unroll
            for (int i = 0; i < 16; ++i) { const int idx = tid + NWG_THREADS * i, t = idx >> 6, ch = idx & 63;
                const float u = bf1(*(const LAS bf16_t*)(UB + t * S5_UP + ch * 2));
                float y = yb[t * 64 + ch] + yb[(128 + t) * 64 + ch] + A.dvec[gb * 64 + ch] * u;
                const float z = 0.7978845608028654f * (y + 0.044715f * y * y * y);
                const float th = 1.0f - 2.0f / (1.0f + __expf(2.0f * z));
                y = 0.5f * y * (1.0f + th);
                A.ssg[(size_t)(t0 + t) * 512 + gb * 64 + ch] = (bf16_t)f2bf(y); }
        }
    }
#undef S5_PREF
}

__device__ __forceinline__ f32x4 mfma16(bf16x8 a, bf16x8 b, f32x4 c) { return __builtin_amdgcn_mfma_f32_16x16x32_bf16(a, b, c, 0, 0, 0); }
constexpr int RET_KP = 528, RET_VP = 136;
constexpr int RET_KB = 64 * RET_KP, RET_VB = 256 * RET_VP, RET_BUF = RET_KB + RET_VB;

__device__ __forceinline__ void ret_task(LAS unsigned char* lds, const bf16_t* p, const bf16_t* vT, bf16_t* mixo, const bf16_t* interf, const bf16_t* interb, const float* ret_decay, int seqtok0, int L, int h, int qb, int tid) {
    asm volatile("" : "+v"(tid));
    const int lane = tid & 63, w = __builtin_amdgcn_readfirstlane(tid >> 6), q = lane & 15, g = lane >> 4;
    const int qrow = qb * 128 + 16 * w + q;
    const float l2f = -expf(ret_decay[h]) * 1.4426950408889634f, l2b = -expf(ret_decay[4 + h]) * 1.4426950408889634f;
    bf16x8 Qf[8];
#pragma unroll
    for (int s = 0; s < 8; ++s) Qf[s] = *(const bf16x8*)(p + (size_t)(seqtok0 + qrow) * P_LD + h * 256 + 32 * s + 8 * g);
    f32x4 Oacc[16];
#pragma unroll
    for (int d = 0; d < 16; ++d) Oacc[d] = (f32x4){0.f, 0.f, 0.f, 0.f};
    constexpr int NKT = RC / 64; const int it0 = ((qb * 128) >> RCL) * NKT; (void)L;
    u32x4 kreg[4], vreg[4];
    const bf16_t* ksrc = p + (size_t)seqtok0 * P_LD + 1024 + h * 256;
    const bf16_t* vsrc = vT + (size_t)(h * 256) * NT + seqtok0;
#define RET_LOAD(it) do { _Pragma("unroll") for (int i = 0; i < 4; ++i) { const int id = tid + NWG_THREADS * i; \
        kreg[i] = *(const u32x4*)(ksrc + (size_t)(64 * (it) + (id >> 5)) * P_LD + 8 * (id & 31)); \
        vreg[i] = *(const u32x4*)(vsrc + (size_t)(id >> 3) * NT + 64 * (it) + 8 * (id & 7)); } } while (0)
#define RET_STORE(buf) do { LAS unsigned char* kb_ = lds + (buf) * RET_BUF; LAS unsigned char* vb_ = kb_ + RET_KB; _Pragma("unroll") for (int i = 0; i < 4; ++i) { const int id = tid + NWG_THREADS * i; \
        *(LAS u32x4*)(kb_ + (id >> 5) * RET_KP + 16 * (id & 31)) = kreg[i]; \
        *(LAS u32x2*)(vb_ + (id >> 3) * RET_VP + 16 * (id & 7)) = (u32x2){vreg[i].x, vreg[i].y}; *(LAS u32x2*)(vb_ + (id >> 3) * RET_VP + 16 * (id & 7) + 8) = (u32x2){vreg[i].z, vreg[i].w}; } } while (0)
    __syncthreads();
    RET_LOAD(it0); RET_STORE(0);
    __syncthreads();
    for (int it = it0; it < it0 + NKT; ++it) {
        if (it + 1 < it0 + NKT) RET_LOAD(it + 1);
        const LAS unsigned char* Kb = lds + ((it - it0) & 1) * RET_BUF; const LAS unsigned char* Vb = Kb + RET_KB;
        f32x4 P[4];
#pragma unroll
        for (int kb = 0; kb < 4; ++kb) {
            f32x4 st = (f32x4){0.f, 0.f, 0.f, 0.f};
#pragma unroll
            for (int s = 0; s < 8; ++s) { const bf16x8 Kf = *(const LAS bf16x8*)(Kb + (16 * kb + q) * RET_KP + 64 * s + 16 * g); st = mfma16(Kf, Qf[s], st); }
#pragma unroll
            for (int r = 0; r < 4; ++r) { const int dist = qrow - (64 * it + 16 * kb + 4 * g + r); const float fd = (float)dist;
                const float arg = dist >= 0 ? fd * l2f : -fd * l2b; st[r] *= __builtin_amdgcn_exp2f(arg); }
            P[kb] = st;
            __builtin_amdgcn_sched_barrier(0);
        }
#pragma unroll
        for (int kp = 0; kp < 2; ++kp) {
            u32x4 pw; pw.x = pk2(P[2 * kp][0], P[2 * kp][1]); pw.y = pk2(P[2 * kp][2], P[2 * kp][3]); pw.z = pk2(P[2 * kp + 1][0], P[2 * kp + 1][1]); pw.w = pk2(P[2 * kp + 1][2], P[2 * kp + 1][3]);
            const bf16x8 Pf = __builtin_bit_cast(bf16x8, pw);
#pragma unroll
            for (int db = 0; db < 16; ++db) { const LAS unsigned char* vp = Vb + (16 * db + q) * RET_VP + 64 * kp + 8 * g;
                const u32x2 lo = *(const LAS u32x2*)vp, hi = *(const LAS u32x2*)(vp + 32);
                const bf16x8 Vf = __builtin_bit_cast(bf16x8, (u32x4){lo.x, lo.y, hi.x, hi.y});
                Oacc[db] = mfma16(Vf, Pf, Oacc[db]);
                if ((db & 3) == 3) __builtin_amdgcn_sched_barrier(0); }
        }
        if (it + 1 < it0 + NKT) RET_STORE((it + 1 - it0) & 1);
        __syncthreads();
    }
#undef RET_LOAD
#undef RET_STORE
    { const size_t tk = (size_t)(seqtok0 + qrow);
#pragma unroll
      for (int d = 0; d < 16; ++d) { const u32x2 wf = *(const u32x2*)(interf + tk * 1024 + h * 256 + 16 * d + 4 * g), wb = *(const u32x2*)(interb + tk * 1024 + h * 256 + 16 * d + 4 * g);
          Oacc[d][0] += bf_lo(wf.x) + bf_lo(wb.x); Oacc[d][1] += bf_hi(wf.x) + bf_hi(wb.x); Oacc[d][2] += bf_lo(wf.y) + bf_lo(wb.y); Oacc[d][3] += bf_hi(wf.y) + bf_hi(wb.y); } }
    float s1 = 0.f;
#pragma unroll
    for (int d = 0; d < 16; ++d) s1 += (Oacc[d][0] + Oacc[d][1]) + (Oacc[d][2] + Oacc[d][3]);
    s1 += __shfl_xor(s1, 16); s1 += __shfl_xor(s1, 32);
    const float mu = s1 * (1.0f / 256.0f); float s2 = 0.f;
#pragma unroll
    for (int d = 0; d < 16; ++d)
#pragma unroll
        for (int r = 0; r < 4; ++r) { const float dd = Oacc[d][r] - mu; s2 += dd * dd; }
    s2 += __shfl_xor(s2, 16); s2 += __shfl_xor(s2, 32);
    const float rstd = 1.0f / sqrtf(s2 * (1.0f / 256.0f) + 1e-6f);
    const size_t tok = (size_t)(seqtok0 + qrow);
#pragma unroll
    for (int d = 0; d < 16; ++d) { const int dvc = 16 * d + 4 * g;
        const u32x2 gw = *(const u32x2*)(p + tok * P_LD + 2048 + h * 256 + dvc);
        const float gt[4] = {bf_lo(gw.x), bf_hi(gw.x), bf_lo(gw.y), bf_hi(gw.y)}; float o[4];
#pragma unroll
        for (int r = 0; r < 4; ++r) { const float sg = gt[r] / (1.0f + __expf(-gt[r])); o[r] = (Oacc[d][r] - mu) * rstd * sg; }
        u32x2 ow; ow.x = pk2(o[0], o[1]); ow.y = pk2(o[2], o[3]);
        *(u32x2*)(mixo + tok * D + h * 256 + dvc) = ow; }
}

__device__ __forceinline__ void na_wave_task(const bf16_t* p, const bf16_t* vT, bf16_t* mixo, const float* rpb, int seqtok0, int rows, int r, int h, int lane) {
    const int q = lane & 15, g = lane >> 4;
    int rs = r - 4; rs = rs < 0 ? 0 : (rs > rows - 8 ? rows - 8 : rs);
    const float* bias = rpb + (size_t)h * 15 * 31;
#pragma unroll 1
    for (int qb = 0; qb < 4; ++qb) {
        const int kc0 = (qb == 0) ? 0 : (qb == 1) ? 8 : (qb == 2) ? 24 : 32;
        const int c = 16 * qb + q; int cs = c - 8; cs = cs < 0 ? 0 : (cs > 48 ? 48 : cs);
        const size_t qtok = (size_t)seqtok0 + (size_t)r * 64 + c;
        bf16x8 Qf[2];
#pragma unroll
        for (int s = 0; s < 2; ++s) Qf[s] = *(const bf16x8*)(p + qtok * P_LD + 3072 + h * 64 + 32 * s + 8 * g);
        f32x4 Oacc[4];
#pragma unroll
        for (int d = 0; d < 4; ++d) Oacc[d] = (f32x4){0.f, 0.f, 0.f, 0.f};
        float mrun = -INFINITY, lrun = 0.f;
#pragma unroll 2
        for (int kr = 0; kr < 8; ++kr) {
            const size_t ktok0 = (size_t)seqtok0 + (size_t)(rs + kr) * 64 + kc0;
            const float* brow = bias + (rs + kr - r + 7) * 31;
            f32x4 S[2];
#pragma unroll
            for (int kb = 0; kb < 2; ++kb) { f32x4 st = (f32x4){0.f, 0.f, 0.f, 0.f};
#pragma unroll
                for (int s = 0; s < 2; ++s) { const bf16x8 Kf = *(const bf16x8*)(p + (ktok0 + 8 * (q >> 2) + 4 * kb + (q & 3)) * P_LD + 4096 + h * 64 + 32 * s + 8 * g); st = mfma16(Kf, Qf[s], st); }
                S[kb] = st; }
            float mx = -INFINITY;
#pragma unroll
            for (int kb = 0; kb < 2; ++kb)
#pragma unroll
                for (int rr = 0; rr < 4; ++rr) { const int kc = kc0 + 8 * g + 4 * kb + rr; const bool ok = (kc >= cs) && (kc < cs + 16);
                    const int co = kc - c + 15; float b = brow[co < 0 ? 0 : (co > 30 ? 30 : co)]; asm("" : "+v"(b));
                    const float v = ok ? S[kb][rr] + b : -INFINITY; S[kb][rr] = v; mx = fmaxf(mx, v); }
            mx = fmaxf(mx, __shfl_xor(mx, 16)); mx = fmaxf(mx, __shfl_xor(mx, 32));
            const float mnew = fmaxf(mrun, mx), alpha = __expf(mrun - mnew);
            float ps = 0.f;
#pragma unroll
            for (int kb = 0; kb < 2; ++kb)
#pragma unroll
                for (int rr = 0; rr < 4; ++rr) { const float e = __expf(S[kb][rr] - mnew); S[kb][rr] = e; ps += e; }
            ps += __shfl_xor(ps, 16); ps += __shfl_xor(ps, 32);
            lrun = lrun * alpha + ps; mrun = mnew;
            u32x4 pw; pw.x = pk2(S[0][0], S[0][1]); pw.y = pk2(S[0][2], S[0][3]); pw.z = pk2(S[1][0], S[1][1]); pw.w = pk2(S[1][2], S[1][3]);
            const bf16x8 Pf = __builtin_bit_cast(bf16x8, pw);
#pragma unroll
            for (int d = 0; d < 4; ++d) { const bf16x8 Vf = *(const bf16x8*)(vT + (size_t)(1024 + h * 64 + 16 * d + q) * NT + ktok0 + 8 * g);
                Oacc[d] = Oacc[d] * alpha; Oacc[d] = mfma16(Vf, Pf, Oacc[d]); }
        }
        const float inv = 1.0f / lrun;
#pragma unroll
        for (int d = 0; d < 4; ++d) { u32x2 ow; ow.x = pk2(Oacc[d][0] * inv, Oacc[d][1] * inv); ow.y = pk2(Oacc[d][2] * inv, Oacc[d][3] * inv);
            *(u32x2*)(mixo + qtok * D + 1024 + h * 64 + 16 * d + 4 * g) = ow; }
    }
}

__device__ __forceinline__ void ret_scan_phase(const bf16_t* UT, bf16_t* ST, const float* rd, int gtid, int NGT) {
    for (int w = gtid; w < 48 * 8192; w += NGT) {
        const int chain = w >> 13, e8 = w & 8191, dir = chain & 1, head = (chain >> 1) & 3, seq = chain >> 3;
        const int c0 = seq < 4 ? seq * (8192 / RC) : 4 * (8192 / RC) + (seq - 4) * (4096 / RC), nc = seq < 4 ? (8192 / RC) : (4096 / RC);
        const float gc = __builtin_amdgcn_exp2f(-expf(rd[dir * 4 + head]) * 1.4426950408889634f * (float)RC);
        float S[8];
#pragma unroll
        for (int e = 0; e < 8; ++e) S[e] = 0.f;
        for (int k = 0; k < nc; ++k) { const int c = dir ? (c0 + nc - 1 - k) : (c0 + k); const size_t off = (size_t)((c * 4 + head) * 2 + dir) * 65536 + (size_t)e8 * 8;
            *(u32x4*)(ST + off) = pack8(S);
            float U[8]; unpack8(*(const u32x4*)(UT + off), U);
#pragma unroll
            for (int e = 0; e < 8; ++e) S[e] = gc * S[e] + U[e]; }
    }
}

#ifndef ONE_LAUNCH
#define ONE_LAUNCH 1
#endif
#ifndef PROBE_MASK
#define PROBE_MASK 0
#endif
#define REPS(k) ((((PROBE_MASK) >> (k)) & 1) ? 2 : 1)
#define REP(k) for (int rep_ = 0; rep_ < REPS(k); ++rep_)
#ifndef PROBE_SUB
#define PROBE_SUB 0
#endif
#define REPSUB(n) for (int reps_ = 0; reps_ < ((((PROBE_SUB) >> (n)) & 1) ? 2 : 1); ++reps_)
#ifndef HOST_PROBE_K
#define HOST_PROBE_K 0
#endif
#ifndef HOST_PROBE_SUB
#define HOST_PROBE_SUB 0
#endif
#ifndef PROBE_HYN
#define PROBE_HYN 1
#endif
#ifndef STOP_PHASE
#define STOP_PHASE 65
#endif
enum { I_XP = 0, I_XS, I_MEMP, I_MEMS, I_NORMG, I_MIXWO, I_EVWIN, I_HYSW, I_HYSB, I_HYW1, I_HYB1, I_HYFREQ, I_HYW2, I_HYB2, I_HYW3, I_HYSKIP, I_HYOUTG,
       I_S5ARE, I_S5AIM, I_S5LOGDT, I_S5BRE, I_S5BIM, I_S5CRE, I_S5CIM, I_S5D, I_S5WGLU, I_ODWIN, I_RETDECAY, I_NARPB, I_MEMNORMG, I_XAWQ, I_XAWKV, I_XAWO, I_FFNWG, I_FFNWU, I_FFNWD, N_INPUTS };
struct Args { const float* in[N_INPUTS]; float* out; unsigned char* ws; int ph_lo, ph_hi; };

constexpr int LDS_PTRTAB = LDS_BYTES - 1024;
__device__ __forceinline__ const float* inptr(LAS unsigned char* lds, int i) {
    const unsigned long long v = ((const LAS unsigned long long*)(lds + LDS_PTRTAB))[i];
    const unsigned lo = __builtin_amdgcn_readfirstlane((unsigned)v), hi = __builtin_amdgcn_readfirstlane((unsigned)(v >> 32));
    return (const float*)(const GAS float*)(((unsigned long long)hi << 32) | lo);
}
#define RUN(id) ((KSEL < 0 || KSEL == ((id) & 15) || (KSEL == 15 && (id) == 64)) && args.ph_lo <= (id) && (id) < args.ph_hi)
#define SEAM() do { if (one) { unsigned long long bi_ = (unsigned long long)args.ws; asm volatile("" : "+s"(bi_)); XcdBarrier b_; b_.bar = (unsigned*)(GAS unsigned*)bi_ + CW_BAR; b_.x = xb_xcc_id(); b_.st = MISC + 8; xcd_barrier(b_, wave_s == 0 && __builtin_amdgcn_mbcnt_hi(~0u, __builtin_amdgcn_mbcnt_lo(~0u, 0u)) == 0u); } } while (0)
#define SUBRUN(n) (SUB < 0 || SUB == (n))
#define PH_BEGIN() unsigned long long wsi_ = (unsigned long long)args.ws, outi_ = (unsigned long long)args.out; int tid = wave_s * 64 + (int)__builtin_amdgcn_mbcnt_hi(~0u, __builtin_amdgcn_mbcnt_lo(~0u, 0u)), wg = blockIdx.x, nwg = gridDim.x; \
    asm volatile("" : "+s"(wsi_), "+s"(outi_), "+v"(tid), "+s"(wg), "+s"(nwg)); \
    unsigned char* const ws = (unsigned char*)(GAS unsigned char*)wsi_; float* const x = (float*)(GAS float*)outi_; unsigned char* const big = ws + WS_BIG; (void)x; (void)big; \
    const int lane = tid & 63, wave = __builtin_amdgcn_readfirstlane(tid >> 6), gw = wg * 8 + wave, NGW = nwg * 8, gtid = wg * NWG_THREADS + tid, NGT = nwg * NWG_THREADS; (void)lane; (void)gw; (void)NGW; (void)gtid; (void)NGT;
#define IN(i) inptr(lds, (i))
#define WP(off) ((bf16_t*)(ws + WS_W + (off)))
#define HBUF ((bf16_t*)(ws + WS_H))
#define XBUF ((bf16_t*)(ws + WS_X))
#define MIXO ((bf16_t*)(ws + WS_MIXO))
#define TMPB ((bf16_t*)(ws + WS_TMP))
#define MEMN ((bf16_t*)(ws + WS_MEMN))
#define KMEM ((bf16_t*)(ws + WS_KMEM))
#define VTM ((bf16_t*)(ws + WS_VT))

template <int KSEL, int SUB, int LAYER> __device__ __forceinline__ void layer_body(const Args& args, LAS unsigned char* lds, volatile LAS unsigned* MISC, const bool one, const int wave_s) {
    constexpr int layer = LAYER;
        const int pb = layer * 16, li = layer >> 1; const bool even = (layer & 1) == 0;
        if (RUN(pb + 0)) { PH_BEGIN();
            const float* ng = IN(I_NORMG) + (size_t)layer * 6 * D;
            if (layer == 0) nrn_phase<0>(IN(I_XP), IN(I_XS), XBUF, x, TMPB, ng, ng, HBUF, gw, NGW, lane);
            else nrn_phase<1>(nullptr, nullptr, XBUF, x, TMPB, ng - D, ng, HBUF, gw, NGW, lane);
            for (int rep_ = 0; rep_ < REPS(0); ++rep_) {
            LAS float* scr = (LAS float*)(lds + wave * 16384);
            if (even) { wt_matrix(IN(I_EVWIN) + (size_t)li * D * 5120, D, 5120, WP(W_IN), MapId{0}, scr, gw, NGW, lane);
                        wt_matrix(IN(I_S5WGLU) + (size_t)li * 512 * 512, 512, 512, WP(W_GLU), MapId{0}, scr, gw, NGW, lane); }
            else wt_matrix(IN(I_ODWIN) + (size_t)li * D * 7168, D, 7168, WP(W_IN), MapOdd{}, scr, gw, NGW, lane);
            wt_matrix(IN(I_MIXWO) + (size_t)layer * D * D, D, D, WP(W_O), MapId{0}, scr, gw, NGW, lane);
            wt_matrix(IN(I_XAWQ) + (size_t)layer * D * D, D, D, WP(W_Q), MapId{0}, scr, gw, NGW, lane);
            wt_matrix(IN(I_XAWKV) + (size_t)layer * D * 2 * D, D, 2 * D, WP(W_KV), MapId{0}, scr, gw, NGW, lane);
            wt_matrix(IN(I_XAWO) + (size_t)layer * D * D, D, D, WP(W_XO), MapId{0}, scr, gw, NGW, lane);
            wt_matrix(IN(I_FFNWG) + (size_t)layer * D * FFN, D, FFN, WP(W_GU), MapGU{0}, scr, gw, NGW, lane);
            wt_matrix(IN(I_FFNWU) + (size_t)layer * D * FFN, D, FFN, WP(W_GU), MapGU{1}, scr, gw, NGW, lane);
            wt_matrix(IN(I_FFNWD) + (size_t)layer * FFN * D, FFN, D, WP(W_D), MapId{0}, scr, gw, NGW, lane);
            memnorm_phase(IN(I_MEMP), IN(I_MEMS), IN(I_MEMNORMG) + (size_t)layer * D, MEMN, gw, NGW, lane);
            if (!even && gtid < 8) ((float*)(ws + WS_L2G))[gtid] = -expf(IN(I_RETDECAY)[li * 8 + gtid]) * 1.4426950408889634f;
            if (layer == 0) tables_phase((f32x2*)(ws + WS_TW), (float*)(ws + WS_ROTC), (float*)(ws + WS_ROTS), gtid, NGT);
            if (even) {
                hyena_hid_phase(IN(I_HYW1) + (size_t)li * 33 * 64, IN(I_HYB1) + li * 64, IN(I_HYFREQ) + li * 128, IN(I_HYW2) + (size_t)li * 4096, IN(I_HYB2) + li * 64, (bf16_t*)(ws + WS_HID2), gw, NGW, lane);
                s5_tables_phase(IN(I_S5ARE) + li * 4096, IN(I_S5AIM) + li * 4096, IN(I_S5LOGDT) + li * 64, IN(I_S5BRE) + (size_t)li * 65536, IN(I_S5BIM) + (size_t)li * 65536, IN(I_S5CRE) + (size_t)li * 65536, IN(I_S5CIM) + (size_t)li * 65536,
                                (f32x2*)(ws + WS_S5T), (bf16_t*)(ws + WS_S5T + 32768), (bf16_t*)(ws + WS_S5T + 32768 + 524288), gtid, NGT);
            }
            }
            SEAM();
        }
        if (RUN(pb + 1)) { REP(1) {
            if (even) {
                { PH_BEGIN(); pg8::StdSched S; S.init(WP(W_IN), D, 4608, HBUF, D, NT, nwg, wg); pg8::EpiBf16 E{(bf16_t*)(big + BIG_PT), NT, 0}; pg8::gemm_phase(lds, tid, D, D, D, S, E); }
                { PH_BEGIN(); pg8::StdSched S; S.init(HBUF, D, NT, WP(W_IN) + (size_t)4608 * D, D, 512, nwg, (wg + 64) % nwg); pg8::EpiBf16 E{(bf16_t*)(big + BIG_U5), 512, 0}; pg8::gemm_phase(lds, tid, D, D, D, S, E); }
            } else {
                { PH_BEGIN(); pg8::StdSched S; S.init(HBUF, D, NT, WP(W_IN), D, 5120, nwg, wg); pg8::EpiRot E{(bf16_t*)(big + BIG_P), P_LD, (const float*)(ws + WS_ROTC), (const float*)(ws + WS_ROTS), TMPB, (const float*)(ws + WS_L2G)}; pg8::gemm_phase(lds, tid, D, D, D, S, E); }
                { PH_BEGIN(); pg8::StdSched S; S.init(WP(W_IN) + (size_t)5120 * D, D, 2048, HBUF, D, NT, nwg, wg); pg8::EpiBf16 E{(bf16_t*)(big + BIG_VT), NT, 0}; pg8::gemm_phase(lds, tid, D, D, D, S, E); }
            }
            { PH_BEGIN(); pg8::StdSched S; S.init(MEMN, D, NMEMTOK, WP(W_KV), D, 2048, nwg, (wg + (even ? 192 : 64)) % nwg); pg8::EpiBf16 E{KMEM, D, 0}; pg8::gemm_phase(lds, tid, D, D, D, S, E); }
            { PH_BEGIN(); pg8::StdSched S; S.init(WP(W_KV) + (size_t)2048 * D, D, 2048, MEMN, D, NMEMTOK, nwg, (wg + (even ? 144 : 112)) % nwg); pg8::EpiBf16 E{VTM, NMEMTOK, 0}; pg8::gemm_phase(lds, tid, D, D, D, S, E); }
            }
            SEAM();
        }
        if (RUN(pb + 2)) { REP(2) {
            if (even) {
#define HY_ARGS() HyArgs H; H.pT = (const bf16_t*)(big + BIG_PT); H.short_w = IN(I_HYSW) + (size_t)li * 3 * 4608; H.short_b = IN(I_HYSB) + (size_t)li * 4608; H.hid2 = (const bf16_t*)(ws + WS_HID2); \
                H.w3 = IN(I_HYW3) + (size_t)li * 64 * 6144; H.skip = IN(I_HYSKIP) + (size_t)li * 2 * HYW; H.TW = (const f32x2*)(ws + WS_TW); H.z2 = HBUF; \
                f32x4* spec = (f32x4*)(ws + WS_HYSCR + (size_t)wg * HYSCR_PER_WG);
                if (SUBRUN(0)) REPSUB(0) { PH_BEGIN(); HY_ARGS(); for (int cp = wg; cp < 768; cp += nwg) hyena_task<14>(lds, H, 2 * cp, 0, 4, spec, tid); }
                if (SUBRUN(1)) REPSUB(1) { PH_BEGIN(); HY_ARGS(); for (int cp = wg; cp < 768; cp += nwg) hyena_task<13>(lds, H, 2 * cp, NPROMPT, 2, spec, tid); }
#undef HY_ARGS
                if (SUBRUN(2)) REPSUB(2) { PH_BEGIN(); S5Args A; A.u5 = (const bf16_t*)(big + BIG_U5); A.lamb = (const f32x2*)(ws + WS_S5T); A.bua = (const bf16_t*)(ws + WS_S5T + 32768);
                    A.cmb = (const bf16_t*)(ws + WS_S5T + 32768 + 524288); A.dvec = IN(I_S5D) + li * 512; A.st = (f32x2*)(ws + WS_S5ST); A.ssg = (bf16_t*)(big + BIG_SSG);
                    s5_phase<0>(lds, A, wg, nwg, tid); }
            } else {
                if (SUBRUN(3)) REPSUB(3) { PH_BEGIN();
                    pg8::RetUSched S{(const char*)(big + BIG_VT), (const char*)TMPB, (const char*)(TMPB + (size_t)1024 * NT), nwg, wg}; pg8::EpiBf16 E{MIXO, 256, 0}; pg8::gemm_phase(lds, tid, RC, NT, NT, S, E); }
            }
            }
            SEAM();
        }
        if (RUN(pb + 3) && !even) {
            if (SUBRUN(0)) { PH_BEGIN(); ret_scan_phase(MIXO, MIXO + (size_t)RUNITS * 65536, IN(I_RETDECAY) + li * 8, gtid, NGT); }
            SEAM();
            if (SUBRUN(1)) { PH_BEGIN(); LAS unsigned long long* slots = (LAS unsigned long long*)(lds + LDS_PTRTAB + 320);
                if (tid == 0) { slots[0] = (unsigned long long)(big + BIG_P); slots[1] = (unsigned long long)(MIXO + (size_t)RUNITS * 65536); }
                __syncthreads();
                pg8::RetISched S{slots, nwg, wg};
                pg8::EpiInter E{HBUF, (const float*)(ws + WS_L2G)}; pg8::gemm_phase(lds, tid, 256, P_LD, 256, S, E); }
            SEAM();
        }
        if (RUN(pb + 3) && even) { REP(3) {
            { PH_BEGIN(); S5Args A; A.u5 = (const bf16_t*)(big + BIG_U5); A.lamb = (const f32x2*)(ws + WS_S5T); A.bua = (const bf16_t*)(ws + WS_S5T + 32768);
              A.cmb = (const bf16_t*)(ws + WS_S5T + 32768 + 524288); A.dvec = IN(I_S5D) + li * 512; A.st = (f32x2*)(ws + WS_S5ST); A.ssg = (bf16_t*)(big + BIG_SSG);
              s5_phase<1>(lds, A, wg, nwg, tid); }
            __syncthreads();
            for (int rh_ = 0; rh_ < PROBE_HYN; ++rh_) { PH_BEGIN(); hyena_norm_phase(lds, HBUF, IN(I_HYOUTG) + (size_t)li * HYW, MIXO, wg, nwg, tid); __syncthreads(); }
            __syncthreads(); }
            SEAM();
        }
        if (RUN(pb + 4) && !even) {
            if (SUBRUN(0)) { PH_BEGIN(); const bf16_t* p = (const bf16_t*)(big + BIG_P); const bf16_t* vT = (const bf16_t*)(big + BIG_VT); const float* rd = IN(I_RETDECAY) + li * 8;
                const int wgp = (nwg == 256) ? ((wg & ~31) | ((wg & 7) << 2) | ((wg >> 3) & 3)) : wg;
                for (int id = wgp; id < 1280; id += nwg) { const bool pr = id < 1024; const int j = id - 1024;
                    ret_task(lds, p, vT, MIXO, HBUF, HBUF + (size_t)NT * 1024, rd, pr ? (id >> 8) * 8192 : NPROMPT + (j >> 7) * 4096, pr ? 8192 : 4096, pr ? (id >> 6) & 3 : (j >> 5) & 3, pr ? id & 63 : j & 31, tid); } }
            if (SUBRUN(1)) { PH_BEGIN(); const bf16_t* p = (const bf16_t*)(big + BIG_P); const bf16_t* vT = (const bf16_t*)(big + BIG_VT); const float* rpb = IN(I_NARPB) + (size_t)li * 16 * 15 * 31;
                for (int k = 0; k < (640 * 16 + NGW - 1) / NGW; ++k) { int id = gw + NGW * k;
                    if (nwg == 256) { const int lw = (wg >> 3) * 8 + wave; id = ((80 * (wg & 7) + 16 * k + (lw >> 4)) << 4) | (lw & 15); }
                    if (id >= 640 * 16) continue;
                    const int h = id & 15, rowid = id >> 4;
                    if (rowid < 512) na_wave_task(p, vT, MIXO, rpb, (rowid >> 7) * 8192, 128, rowid & 127, h, lane);
                    else { const int rr = rowid - 512; na_wave_task(p, vT, MIXO, rpb, NPROMPT + (rr >> 6) * 4096, 64, rr & 63, h, lane); } } }
            SEAM();
        }
        if (RUN(pb + 4) && even) { REP(4) { PH_BEGIN();
            pg8::StdSched S; S.init((const bf16_t*)(big + BIG_SSG), 512, NT, WP(W_GLU), 512, 512, nwg, wg);
            pg8::EpiGLU E{(const bf16_t*)(big + BIG_SSG), MIXO, 512, D, HYW}; asm volatile("" : "+v"(tid)); pg8::gemm_phase(lds, tid, 512, 512, 512, S, E); }
            SEAM();
        }
        if (RUN(pb + 5)) { REP(5) { PH_BEGIN(); pg8::StdSched S; S.init(MIXO, D, NT, WP(W_O), D, D, nwg, wg); pg8::EpiBf16 E{TMPB, D, 0}; asm volatile("" : "+v"(tid)); pg8::gemm_phase(lds, tid, D, D, D, S, E); } SEAM(); }
        if (RUN(pb + 6)) { PH_BEGIN(); const float* ng = IN(I_NORMG) + (size_t)layer * 6 * D; nrn_phase<1>(nullptr, nullptr, XBUF, x, TMPB, ng + D, ng + 2 * D, HBUF, gw, NGW, lane); SEAM(); }
        if (RUN(pb + 7)) { REP(7) { PH_BEGIN(); pg8::StdSched S; S.init(HBUF, D, NT, WP(W_Q), D, D, nwg, wg); pg8::EpiBf16 E{(bf16_t*)(big + BIG_Q), D, 0}; asm volatile("" : "+v"(tid)); pg8::gemm_phase(lds, tid, D, D, D, S, E); } SEAM(); }
        if (RUN(pb + 8)) { REP(8) { PH_BEGIN(); pg8::QKSched S{(const char*)(big + BIG_Q), (const char*)KMEM, nwg, wg}; pg8::EpiF32 E{(float*)(big + BIG_S), 1024, 256, 0.044194173824159216f}; asm volatile("" : "+v"(tid)); pg8::gemm_phase(lds, tid, 512, D, D, S, E); } SEAM(); }
        if (RUN(pb + 9)) { REP(9) { PH_BEGIN(); softmax_phase((const float*)(big + BIG_S), (bf16_t*)(big + BIG_PB), gw, NGW, lane); } SEAM(); }
        if (RUN(pb + 10)) { REP(10) { PH_BEGIN(); pg8::PVSched S{(const char*)(big + BIG_PB), (const char*)VTM, nwg, wg}; pg8::EpiBf16 E{(bf16_t*)(big + BIG_O), D, 512}; asm volatile("" : "+v"(tid)); pg8::gemm_phase(lds, tid, 256, 1024, NMEMTOK, S, E); } SEAM(); }
        if (RUN(pb + 11)) { REP(11) { PH_BEGIN(); pg8::StdSched S; S.init((const bf16_t*)(big + BIG_O), D, NT, WP(W_XO), D, D, nwg, wg); pg8::EpiBf16 E{TMPB, D, 0}; asm volatile("" : "+v"(tid)); pg8::gemm_phase(lds, tid, D, D, D, S, E); } SEAM(); }
        if (RUN(pb + 12)) { PH_BEGIN(); const float* ng = IN(I_NORMG) + (size_t)layer * 6 * D; nrn_phase<1>(nullptr, nullptr, XBUF, x, TMPB, ng + 3 * D, ng + 4 * D, HBUF, gw, NGW, lane); SEAM(); }
        if (RUN(pb + 13)) { REP(13) { PH_BEGIN(); pg8::StdSched S; S.init(HBUF, D, NT, WP(W_GU), D, 2 * FFN, nwg, wg); pg8::EpiSwiGLU E{(bf16_t*)(big + BIG_HID), FFN}; asm volatile("" : "+v"(tid)); pg8::gemm_phase(lds, tid, D, D, D, S, E); } SEAM(); }
        if (RUN(pb + 14)) { REP(14) { PH_BEGIN(); pg8::StdSched S; S.init((const bf16_t*)(big + BIG_HID), FFN, NT, WP(W_D), FFN, D, nwg, wg); pg8::EpiBf16 E{TMPB, D, 0}; asm volatile("" : "+v"(tid)); pg8::gemm_phase(lds, tid, FFN, FFN, FFN, S, E); } SEAM(); }
    }

template <int KSEL, int SUB> __device__ __forceinline__ void trunk_body(const Args& args) {
    extern __shared__ __attribute__((aligned(16))) unsigned char lds_raw[];
    LAS unsigned char* lds = (LAS unsigned char*)lds_raw;
    const bool one = (args.ph_hi - args.ph_lo) > 1;
    volatile LAS unsigned* MISC = (volatile LAS unsigned*)(lds + LDS_MISC);
    if (threadIdx.x < 64) MISC[threadIdx.x] = 0u;
    if (threadIdx.x == 0) {
#pragma unroll
        for (int i = 0; i < N_INPUTS; ++i) ((LAS unsigned long long*)(lds + LDS_PTRTAB))[i] = (unsigned long long)args.in[i];
    }
    __syncthreads();
    const int wave_s = __builtin_amdgcn_readfirstlane((int)threadIdx.x >> 6);
    if (one) (void)xcd_barrier_post((unsigned*)args.ws + CW_BAR, MISC + 8, threadIdx.x == 0);
    layer_body<KSEL, SUB, 0>(args, lds, MISC, one, wave_s);
    layer_body<KSEL, SUB, 1>(args, lds, MISC, one, wave_s);
    layer_body<KSEL, SUB, 2>(args, lds, MISC, one, wave_s);
    layer_body<KSEL, SUB, 3>(args, lds, MISC, one, wave_s);
    if (RUN(64)) { PH_BEGIN(); const float* ng = IN(I_NORMG) + (size_t)3 * 6 * D; nrn_phase<2>(nullptr, nullptr, XBUF, x, TMPB, ng + 5 * D, ng, HBUF, gw, NGW, lane); }
#undef RUN
#undef SEAM
}

template <int KSEL, int SUB> __global__ void __launch_bounds__(NWG_THREADS, 2) trunk_k(Args args) { trunk_body<KSEL, SUB>(args); }

static bool phase_nonempty(int id) {
    if (id == 64) return true;
    const int layer = id >> 4, k = id & 15; if (layer >= DEPTH || k > 14) return false;
    return true;
}
typedef void (*kern_t)(Args);
static kern_t kern_of(int k, int sub) {
    switch (k) {
#if ONE_LAUNCH
        default: return trunk_k<-1, -1>;
#else
        case 0: return trunk_k<0, -1>; case 1: return trunk_k<1, -1>;
        case 3: switch (sub) { case 0: return trunk_k<3, 0>; case 1: return trunk_k<3, 1>; default: return trunk_k<3, -1>; }
        case 4: switch (sub) { case 0: return trunk_k<4, 0>; case 1: return trunk_k<4, 1>; default: return trunk_k<4, -1>; } case 5: return trunk_k<5, -1>; case 6: return trunk_k<6, -1>; case 7: return trunk_k<7, -1>;
        case 8: return trunk_k<8, -1>; case 9: return trunk_k<9, -1>; case 10: return trunk_k<10, -1>; case 11: return trunk_k<11, -1>; case 12: return trunk_k<12, -1>; case 13: return trunk_k<13, -1>; case 14: return trunk_k<14, -1>;
        case 2: switch (sub) { case 0: return trunk_k<2, 0>; case 1: return trunk_k<2, 1>; case 2: return trunk_k<2, 2>; case 3: return trunk_k<2, 3>; default: return trunk_k<2, 4>; }
        default: return trunk_k<15, -1>;
#endif
    }
}
extern "C" void kernel_launch(void* const* d_in, const int* in_sizes, int n_in, void* d_out, int out_size, void* d_ws, size_t ws_size, hipStream_t stream) {
    static int grid = 0;
    if (grid == 0) {
        if (n_in != N_INPUTS || out_size != NT * D || ws_size < WS_END) { fprintf(stderr, "kernel_launch: unexpected problem (n_in %d out %d ws %zu, need %zu)\n", n_in, out_size, ws_size, (size_t)WS_END); grid = -1; return; }
        int dev = 0, cus = 0;
        if (hipGetDevice(&dev) != hipSuccess || hipDeviceGetAttribute(&cus, hipDeviceAttributeMultiprocessorCount, dev) != hipSuccess) { grid = -1; return; }
        for (int k = 0; k < 16 * 5; ++k) if (hipFuncSetAttribute((const void*)kern_of(k / 5, k % 5), hipFuncAttributeMaxDynamicSharedMemorySize, LDS_BYTES) != hipSuccess) { fprintf(stderr, "kernel_launch: hipFuncSetAttribute failed\n"); grid = -1; return; }
        (void)hipGetLastError();
        grid = cus < 256 ? cus : 256;
    }
    if (grid < 0) return;
    (void)hipMemsetAsync((char*)d_ws + WS_CTL, 0, 1 * MiB, stream);
    Args a{};
    for (int i = 0; i < N_INPUTS; ++i) a.in[i] = (const float*)d_in[i];
    a.out = (float*)d_out; a.ws = (unsigned char*)d_ws;
#if ONE_LAUNCH
    a.ph_lo = 0; a.ph_hi = STOP_PHASE;
    hipLaunchKernelGGL(kern_of(0, 0), dim3(grid), dim3(NWG_THREADS), LDS_BYTES, stream, a);
#else
    for (int id = 0; id < STOP_PHASE; ++id) { if (!phase_nonempty(id)) continue; a.ph_lo = id; a.ph_hi = id + 1;
        const int k = id == 64 ? 15 : (id & 15); const bool odd = (id >> 4) & 1;
        if (odd && (k == 3 || k == 4)) { hipLaunchKernelGGL(kern_of(k, 0), dim3(grid), dim3(NWG_THREADS), LDS_BYTES, stream, a); hipLaunchKernelGGL(kern_of(k, 1), dim3(grid), dim3(NWG_THREADS), LDS_BYTES, stream, a); }
        else if (k == 2) { for (int sub = odd ? 3 : 0; sub < (odd ? 4 : 3); ++sub) for (int r = 0; r < ((((HOST_PROBE_SUB) >> sub) & 1) ? 2 : 1); ++r) hipLaunchKernelGGL(kern_of(2, sub), dim3(grid), dim3(NWG_THREADS), LDS_BYTES, stream, a); }
        else for (int r = 0; r < ((((HOST_PROBE_K) >> k) & 1) ? 2 : 1); ++r) hipLaunchKernelGGL(kern_of(k, 2), dim3(grid), dim3(NWG_THREADS), LDS_BYTES, stream, a); }
#endif
}
```

```cpp
#include <hip/hip_runtime.h>
#include <cstdio>
#include <cstdint>

#define LAS __attribute__((address_space(3)))
#define GAS __attribute__((address_space(1)))
typedef unsigned short bf16_t;
typedef short bf16x8 __attribute__((ext_vector_type(8)));
typedef float f32x4 __attribute__((ext_vector_type(4)));
typedef float f32x16 __attribute__((ext_vector_type(16)));
typedef float f32x2 __attribute__((ext_vector_type(2)));
typedef unsigned u32x4 __attribute__((ext_vector_type(4)));
typedef unsigned u32x2 __attribute__((ext_vector_type(2)));
#define MK2(a, b) ((f32x2){(a), (b)})
#define MK4(a, b, c, d) ((f32x4){(a), (b), (c), (d)})

constexpr int D = 2048, NT = 40960, NPROMPT = 32768, DEPTH = 4;
constexpr int HYW = 1536, S5W = 512, FFN = 5632, NMEM = 256, NMEMTOK = 1536;
constexpr int NWG_THREADS = 512;
constexpr int RCL = 9, RC = 1 << RCL, RNCH = NT / RC, RUNITS = RNCH * 8;
constexpr int P_LD = 5120;
constexpr float RMS_EPS = 1e-6f;

constexpr size_t MiB = 1u << 20;
constexpr size_t WS_CTL = 0;
constexpr size_t WS_TW = 1 * MiB;
constexpr size_t WS_ROTC = 2 * MiB, WS_ROTS = 6 * MiB;
constexpr size_t WS_HID2 = 10 * MiB;
constexpr size_t WS_S5T = 13 * MiB;
constexpr size_t WS_MEMN = 14 * MiB, WS_KMEM = 20 * MiB, WS_VT = 26 * MiB;
constexpr size_t WS_W = 32 * MiB;
constexpr size_t W_IN = 0, W_O = 28 * MiB, W_Q = 36 * MiB, W_KV = 44 * MiB, W_XO = 60 * MiB, W_GU = 68 * MiB, W_D = 112 * MiB, W_GLU = 134 * MiB;
constexpr size_t WS_H = 176 * MiB, WS_MIXO = 336 * MiB, WS_TMP = 496 * MiB, WS_BIG = 656 * MiB, WS_X = 1216 * MiB, WS_END = 1376 * MiB;
constexpr size_t HYSCR_PER_WG = 328 * 1024;
constexpr size_t WS_HYSCR = WS_TMP, WS_S5ST = WS_TMP + 96 * MiB;
constexpr size_t BIG_PT = 0, BIG_U5 = 360 * MiB, BIG_SSG = 440 * MiB;
constexpr size_t BIG_P = 0, BIG_VT = 400 * MiB;
constexpr size_t BIG_Q = 0, BIG_S = 160 * MiB, BIG_PB = 320 * MiB, BIG_O = 400 * MiB;
constexpr size_t BIG_HID = 0;
constexpr int CW_BAR = 4096;
constexpr size_t WS_L2G = 512 * 1024;

constexpr int LDS_BYTES = 163840;
constexpr int LDS_MISC = LDS_BYTES - 256;

__device__ __forceinline__ unsigned f2bf(float f) { unsigned u = __builtin_bit_cast(unsigned, f); return (u + 0x7fffu + ((u >> 16) & 1u)) >> 16; }
__device__ __forceinline__ unsigned pk2(float lo, float hi) { unsigned r; asm volatile("v_cvt_pk_bf16_f32 %0, %1, %2" : "=v"(r) : "v"(lo), "v"(hi)); return r; }
__device__ __forceinline__ float bf_lo(unsigned w) { return __builtin_bit_cast(float, w << 16); }
__device__ __forceinline__ float bf_hi(unsigned w) { return __builtin_bit_cast(float, w & 0xffff0000u); }
__device__ __forceinline__ float bf1(bf16_t b) { return __builtin_bit_cast(float, ((unsigned)b) << 16); }
__device__ __forceinline__ float wave_sum(float v) {
#pragma unroll
    for (int o = 1; o < 64; o <<= 1) v += __shfl_xor(v, o);
    return v;
}
__device__ __forceinline__ float wave_max(float v) {
#pragma unroll
    for (int o = 1; o < 64; o <<= 1) v = fmaxf(v, __shfl_xor(v, o));
    return v;
}
#define LDS_WAIT() asm volatile("s_waitcnt lgkmcnt(0)" ::: "memory")
#define VM_WAIT() asm volatile("s_waitcnt vmcnt(0)" ::: "memory")

__device__ __forceinline__ void tok_info(int t, int& seq, int& l, int& L) {
    if (t < NPROMPT) { seq = t >> 13; l = t & 8191; L = 8192; } else { const int u = t - NPROMPT; seq = 4 + (u >> 12); l = u & 4095; L = 4096; }
}

#define XB_TMO      128
#define XB_XCNT(j)  (256  + 64 * (j))
#define XB_XSUB(j)  (1280 + 64 * (j))
#define XB_XGEN(j)  (2304 + 64 * (j))
#define XB_TOP      3328
#define XB_TOPGEN   3392
#define XCD_BAR_WORDS 3456
#define XB_SPIN_CAP (1u << 22)
__device__ __forceinline__ unsigned xb_ld(unsigned* p)              { return __hip_atomic_load(p, __ATOMIC_RELAXED, __HIP_MEMORY_SCOPE_AGENT); }
__device__ __forceinline__ unsigned xb_add(unsigned* p, unsigned v) { return __hip_atomic_fetch_add(p, v, __ATOMIC_RELAXED, __HIP_MEMORY_SCOPE_AGENT); }
__device__ __forceinline__ unsigned xb_xcc_id() { return (unsigned)__builtin_amdgcn_s_getreg((3 << 11) | 20) & 0xFu; }
#define XB_SPIN(cond, bar) do { unsigned _sp = 0; while (cond) { __builtin_amdgcn_s_sleep(1); \
    if ((++_sp & 255u) == 0u) { if (xb_ld(&(bar)[XB_TMO])) break; if (_sp > XB_SPIN_CAP) { atomicAdd(&(bar)[XB_TMO], 1u); break; } } } } while (0)
struct XcdBarrier { unsigned* bar; unsigned x; volatile LAS unsigned* st; };
__device__ __forceinline__ XcdBarrier xcd_barrier_post(unsigned* bar, volatile LAS unsigned* st, const bool t0) {
    XcdBarrier b; b.bar = bar; b.x = xb_xcc_id(); b.st = st;
    if (t0) (void)xb_add(&bar[XB_XCNT(b.x)], 1u);
    return b;
}
__device__ __forceinline__ void xcd_barrier_complete(unsigned* bar, unsigned x, unsigned& nloc, unsigned& nx) {
    const unsigned G = gridDim.x * gridDim.y * gridDim.z;
    unsigned sum, cnt, mine, sp = 0u;
    for (;;) {
        sum = 0u; cnt = 0u; mine = 0u;
#pragma unroll
        for (unsigned j = 0; j < 16; ++j) { const unsigned c = xb_ld(&bar[XB_XCNT(j)]); sum += c; cnt += (c > 0u) ? 1u : 0u; mine = (j == x) ? c : mine; }
        if (sum == G) break;
        __builtin_amdgcn_s_sleep(1);
        if ((++sp & 255u) == 0u) { if (xb_ld(&bar[XB_TMO])) break; if (sp > XB_SPIN_CAP) { atomicAdd(&bar[XB_TMO], 1u); break; } }
    }
    nloc = mine > 0u ? mine : 1u; nx = cnt > 0u ? cnt : 1u;
}
__device__ __forceinline__ void xcd_barrier(const XcdBarrier& b, const bool t0) {
    asm volatile("s_waitcnt vmcnt(0)" ::: "memory");
    __syncthreads();
    if (t0) {
        unsigned* bar = b.bar;
        __builtin_amdgcn_s_waitcnt(0);
        unsigned nloc = b.st[0], nx = b.st[1];
        if (nloc == 0u) { xcd_barrier_complete(bar, b.x, nloc, nx); b.st[0] = nloc; b.st[1] = nx; }
        const unsigned old = xb_add(&bar[XB_XSUB(b.x)], 1u);
        const unsigned gen = old / nloc;
        if (old + 1u == (gen + 1u) * nloc) {
            __builtin_amdgcn_fence(__ATOMIC_RELEASE, "agent");
            asm volatile("s_waitcnt vmcnt(0)" ::: "memory");
            const unsigned og = xb_add(&bar[XB_TOP], 1u);
            const unsigned tg = og / nx;
            if (og + 1u == (tg + 1u) * nx) xb_add(&bar[XB_TOPGEN], 1u);
            else XB_SPIN(xb_ld(&bar[XB_TOPGEN]) == tg, bar);
            __builtin_amdgcn_fence(__ATOMIC_ACQUIRE, "agent");
            xb_add(&bar[XB_XGEN(b.x)], 1u);
            asm volatile("s_waitcnt vmcnt(0)" ::: "memory");
        } else {
            XB_SPIN(xb_ld(&bar[XB_XGEN(b.x)]) == gen, bar);
            __builtin_amdgcn_fence(__ATOMIC_ACQUIRE, "agent");
            asm volatile("s_waitcnt vmcnt(0)" ::: "memory");
        }
    }
    __syncthreads();
}

namespace pg8 {
constexpr int BM = 256, BK = 64, HALF = 128, HTB = HALF * BK * 2, STAGE_BYTES = 8 * HTB, NXCD = 8, WGM = 8;
__host__ __device__ __forceinline__ int lds_byte(int r, int c) { const int st = (r >> 4) * 2 + (c >> 5), rr = r & 15, cc = c & 31, ob = rr * 64 + cc * 2; return st * 1024 + (ob ^ (((ob >> 9) & 1) << 5)); }
__host__ __device__ __forceinline__ void stage_rc(int b, int& R, int& C) { const int st = b / 1024, sb = b % 1024, swz = sb ^ (((sb >> 9) & 1) << 5); R = (st >> 1) * 16 + swz / 64; C = (st & 1) * 32 + (swz % 64) / 2; }
__host__ __device__ __forceinline__ int perm32(int rho) { const int n = rho >> 4, i = rho & 15; return 8 * (i >> 2) + 4 * n + (i & 3); }
struct Unit { int pm, pn, z; };

struct StdSched {
    const char* A; const char* Bt; size_t tsA, tsB; int nM, nN, nwg, G, c;
    __device__ __forceinline__ void init(const bf16_t* A_, int lda, int M, const bf16_t* Bt_, int ldb, int N, int G_, int c_) {
        A = (const char*)A_; Bt = (const char*)Bt_; tsA = (size_t)BM * lda * 2; tsB = (size_t)BM * ldb * 2; nM = M / BM; nN = N / BM; nwg = nM * nN; G = G_; c = c_; }
    __device__ __forceinline__ bool next(int i, Unit& u) const {
        const long L = (long)i * G + c; if (L >= nwg) return false;
        int wgid = (int)L; { const int q = nwg / NXCD, r = nwg % NXCD, xcd = wgid % NXCD, off = wgid / NXCD; wgid = (xcd < r ? xcd * (q + 1) : r * (q + 1) + (xcd - r) * q) + off; }
        const int nig = WGM * nN, gid = wgid / nig, fm = gid * WGM, gsz = (nM - fm) < WGM ? (nM - fm) : WGM;
        u.pm = fm + ((wgid % nig) % gsz); u.pn = (wgid % nig) / gsz; u.z = 0; return true;
    }
    __device__ __forceinline__ const char* a_ptr(const Unit& u) const { return A + (size_t)u.pm * tsA; }
    __device__ __forceinline__ const char* b_ptr(const Unit& u) const { return Bt + (size_t)u.pn * tsB; }
};
__device__ __forceinline__ int seq_of_tile(int pmg) { return pmg < 128 ? (pmg >> 5) : 4 + ((pmg - 128) >> 4); }
struct QKSched {
    const char* Q; const char* Km; int G, c;
    __device__ __forceinline__ bool next(int i, Unit& u) const { const int idx = i * G + c; if (idx >= 640) return false; u.z = idx & 3; u.pm = idx >> 2; u.pn = 0; return true; }
    __device__ __forceinline__ const char* a_ptr(const Unit& u) const { return Q + ((size_t)u.pm * 256 * D + (size_t)u.z * 512) * 2; }
    __device__ __forceinline__ const char* b_ptr(const Unit& u) const { return Km + ((size_t)seq_of_tile(u.pm) * 256 * D + (size_t)u.z * 512) * 2; }
};
struct PVSched {
    const char* P; const char* VT; int G, c;
    __device__ __forceinline__ bool next(int i, Unit& u) const { const int idx = i * G + c; if (idx >= 1280) return false; u.pn = idx & 1; u.z = (idx >> 1) & 3; u.pm = idx >> 3; return true; }
    __device__ __forceinline__ const char* a_ptr(const Unit& u) const { return P + ((size_t)u.pm * 256 * 1024 + (size_t)u.z * 256) * 2; }
    __device__ __forceinline__ const char* b_ptr(const Unit& u) const { return VT + ((size_t)(u.z * 512 + u.pn * 256) * NMEMTOK + (size_t)seq_of_tile(u.pm) * 256) * 2; }
};

struct EpiBf16 {
    static constexpr bool PERM = true;
    bf16_t* O; int ldc; int zcol;
    __device__ __forceinline__ void operator()(const f32x4 (&acc)[2][2][4][2], const Unit& u, int wr, int wc, int fr, int fq) const {
        const int row0 = u.pm * BM + wr * 64 + fr; const int col0 = u.pn * BM + u.z * zcol + wc * 32 + 8 * fq;
#pragma unroll
        for (int ai = 0; ai < 2; ++ai)
#pragma unroll
            for (int m = 0; m < 4; ++m) { bf16_t* rowp = O + (size_t)(row0 + ai * HALF + m * 16) * ldc + col0;
#pragma unroll
                for (int bj = 0; bj < 2; ++bj) { const f32x4 v0 = acc[ai][bj][m][0], v1 = acc[ai][bj][m][1];
                    u32x4 w; w.x = pk2(v0[0], v0[1]); w.y = pk2(v0[2], v0[3]); w.z = pk2(v1[0], v1[1]); w.w = pk2(v1[2], v1[3]);
                    *(u32x4*)(rowp + bj * HALF) = w; } }
    }
};
struct EpiF32 {
    static constexpr bool PERM = false;
    float* C; int ldc; int zcol; float scale;
    __device__ __forceinline__ void operator()(const f32x4 (&acc)[2][2][4][2], const Unit& u, int wr, int wc, int fr, int fq) const {
        const int row0 = u.pm * BM + wr * 64 + fr, col0 = u.pn * BM + u.z * zcol + wc * 32 + 4 * fq;
#pragma unroll
        for (int ai = 0; ai < 2; ++ai)
#pragma unroll
            for (int m = 0; m < 4; ++m) { float* rowp = C + (size_t)(row0 + ai * HALF + m * 16) * ldc + col0;
#pragma unroll
                for (int bj = 0; bj < 2; ++bj)
#pragma unroll
                    for (int n = 0; n < 2; ++n) *(f32x4*)(rowp + bj * HALF + n * 16) = acc[ai][bj][m][n] * scale; }
    }
};
struct EpiSwiGLU {
    static constexpr bool PERM = false;
    bf16_t* O; int ldc;
    __device__ __forceinline__ void operator()(const f32x4 (&acc)[2][2][4][2], const Unit& u, int wr, int wc, int fr, int fq) const {
        const int row0 = u.pm * BM + wr * 64 + fr; const int colh = (u.pn * BM + wc * 32) / 2 + 4 * fq;
#pragma unroll
        for (int ai = 0; ai < 2; ++ai)
#pragma unroll
            for (int m = 0; m < 4; ++m) { bf16_t* rowp = O + (size_t)(row0 + ai * HALF + m * 16) * ldc + colh;
#pragma unroll
                for (int bj = 0; bj < 2; ++bj) { const f32x4 g = acc[ai][bj][m][0], up = acc[ai][bj][m][1]; float o[4];
#pragma unroll
                    for (int j = 0; j < 4; ++j) { const float s = g[j] * __builtin_amdgcn_rcpf(1.0f + __builtin_amdgcn_exp2f(-1.4426950408889634f * g[j])); o[j] = s * up[j]; }
                    u32x2 w; w.x = pk2(o[0], o[1]); w.y = pk2(o[2], o[3]);
                    *(u32x2*)(rowp + bj * (HALF / 2)) = w; } }
    }
};
struct EpiGLU {
    static constexpr bool PERM = true;
    const bf16_t* G; bf16_t* O; int ldg, ldo, ocol;
    __device__ __forceinline__ void operator()(const f32x4 (&acc)[2][2][4][2], const Unit& u, int wr, int wc, int fr, int fq) const {
        const int row0 = u.pm * BM + wr * 64 + fr; const int col0 = u.pn * BM + wc * 32 + 8 * fq;
#pragma unroll
        for (int ai = 0; ai < 2; ++ai)
#pragma unroll
            for (int m = 0; m < 4; ++m) { const size_t r = (size_t)(row0 + ai * HALF + m * 16);
                const u32x4 gv2[2] = {*(const u32x4*)(G + r * ldg + col0), *(const u32x4*)(G + r * ldg + col0 + HALF)};
#pragma unroll
                for (int bj = 0; bj < 2; ++bj) { const f32x4 v0 = acc[ai][bj][m][0], v1 = acc[ai][bj][m][1];
                    const u32x4 gv = gv2[bj];
                    float o[8]; const float a[8] = {v0[0], v0[1], v0[2], v0[3], v1[0], v1[1], v1[2], v1[3]};
                    const float y[8] = {bf_lo(gv.x), bf_hi(gv.x), bf_lo(gv.y), bf_hi(gv.y), bf_lo(gv.z), bf_hi(gv.z), bf_lo(gv.w), bf_hi(gv.w)};
#pragma unroll
                    for (int j = 0; j < 8; ++j) o[j] = y[j] / (1.0f + __expf(-a[j]));
                    u32x4 w; w.x = pk2(o[0], o[1]); w.y = pk2(o[2], o[3]); w.z = pk2(o[4], o[5]); w.w = pk2(o[6], o[7]);
                    *(u32x4*)(O + r * ldo + ocol + col0 + bj * HALF) = w; } }
    }
};
struct EpiRot {
    static constexpr bool PERM = true;
    bf16_t* O; int ldc; const float* rc; const float* rs;
    bf16_t* Kf; const float* rd;
    __device__ __forceinline__ void operator()(const f32x4 (&acc)[2][2][4][2], const Unit& u, int wr, int wc, int fr, int fq) const {
        const int row0 = u.pm * BM + wr * 64 + fr; const int col0 = u.pn * BM + wc * 32 + 8 * fq; const bool rot = u.pn < 8; const bool kt = (u.pn >> 2) == 1;
        const int head = u.pn & 3; float l2f = 0.f, l2b = 0.f; if (kt) { l2f = rd[head]; l2b = rd[4 + head]; }
#pragma unroll
        for (int ai = 0; ai < 2; ++ai)
#pragma unroll
            for (int m = 0; m < 4; ++m) { const int r = row0 + ai * HALF + m * 16; bf16_t* rowp = O + (size_t)r * ldc + col0;
                const int pos = (r < NPROMPT) ? (r & 8191) : ((r - NPROMPT) & 4095); const unsigned toff = (unsigned)(pos * 128 + wc * 32 + 8 * fq);
                u32x4 wa, wb;
#pragma unroll
                for (int n = 0; n < 2; ++n) { f32x4 a = acc[ai][0][m][n], b = acc[ai][1][m][n];
                    if (rot) { const f32x4 c = *(const f32x4*)(rc + toff + 4 * n), sn = *(const f32x4*)(rs + toff + 4 * n); const f32x4 x = a * c - b * sn, y = a * sn + b * c; a = x; b = y; }
                    if (n == 0) { wa.x = pk2(a[0], a[1]); wa.y = pk2(a[2], a[3]); wb.x = pk2(b[0], b[1]); wb.y = pk2(b[2], b[3]); }
                    else { wa.z = pk2(a[0], a[1]); wa.w = pk2(a[2], a[3]); wb.z = pk2(b[0], b[1]); wb.w = pk2(b[2], b[3]); }
                    if (kt) {
                        const int ic = r & (RC - 1); const float ff = __builtin_amdgcn_exp2f(l2f * (float)(RC - 1 - ic)), fb = __builtin_amdgcn_exp2f(l2b * (float)ic);
                        bf16_t* kp = Kf + (size_t)(head * 256 + wc * 32 + 8 * fq + 4 * n) * NT + r;
#pragma unroll
                        for (int j = 0; j < 4; ++j) {
                            kp[(size_t)j * NT] = (bf16_t)pk2(a[j] * ff, 0.f); kp[(size_t)(j + 128) * NT] = (bf16_t)pk2(b[j] * ff, 0.f);
                            kp[(size_t)(1024 + j) * NT] = (bf16_t)pk2(a[j] * fb, 0.f); kp[(size_t)(1024 + j + 128) * NT] = (bf16_t)pk2(b[j] * fb, 0.f); } } }
                *(u32x4*)(rowp) = wa; *(u32x4*)(rowp + HALF) = wb;
                asm volatile("" ::: "memory"); }
    }
};

struct RetUSched {
    const char* vT; const char* kTf; const char* kTb; int G, c;
    __device__ __forceinline__ bool next(int i, Unit& u) const { const int idx = i * G + c; if (idx >= RUNITS) return false; u.pm = idx; u.pn = 0; u.z = 0; return true; }
    __device__ __forceinline__ const char* a_ptr(const Unit& u) const { const int head = (u.pm >> 1) & 3, chunk = u.pm >> 3; return vT + ((size_t)(head * 256) * NT + (size_t)chunk * RC) * 2; }
    __device__ __forceinline__ const char* b_ptr(const Unit& u) const { const int head = (u.pm >> 1) & 3, chunk = u.pm >> 3; return ((u.pm & 1) ? kTb : kTf) + ((size_t)(head * 256) * NT + (size_t)chunk * RC) * 2; }
};
struct RetISched {
    const LAS unsigned long long* slots; int G, c;
    __device__ __forceinline__ const char* base(int i) const { const unsigned long long v = slots[i]; const unsigned lo = __builtin_amdgcn_readfirstlane((unsigned)v), hi = __builtin_amdgcn_readfirstlane((unsigned)(v >> 32));
        return (const char*)(const GAS char*)(((unsigned long long)hi << 32) | lo); }
    __device__ __forceinline__ bool next(int i, Unit& u) const { const int idx = i * G + c; if (idx >= 1280) return false; u.z = idx & 7; u.pm = idx >> 3; u.pn = 0; return true; }
    __device__ __forceinline__ const char* a_ptr(const Unit& u) const { return base(0) + ((size_t)u.pm * 256 * P_LD + (size_t)(u.z >> 1) * 256) * 2; }
    __device__ __forceinline__ const char* b_ptr(const Unit& u) const { return base(1) + (size_t)(((u.pm >> (RCL - 8)) * 4 + (u.z >> 1)) * 2 + (u.z & 1)) * 65536 * 2; }
};
struct EpiInter {
    static constexpr bool PERM = true;
    bf16_t* Of; const float* rd;
    __device__ __forceinline__ void operator()(const f32x4 (&acc)[2][2][4][2], const Unit& u, int wr, int wc, int fr, int fq) const {
        const int head = u.z >> 1, dir = u.z & 1; const float l2 = rd[dir * 4 + head]; bf16_t* O = Of + (size_t)dir * NT * 1024;
        const int row0 = u.pm * BM + wr * 64 + fr; const int col0 = head * 256 + wc * 32 + 8 * fq;
#pragma unroll
        for (int ai = 0; ai < 2; ++ai)
#pragma unroll
            for (int m = 0; m < 4; ++m) { const int r = row0 + ai * HALF + m * 16, i = r & (RC - 1); const float sc = __builtin_amdgcn_exp2f(l2 * (float)(dir ? RC - i : i + 1));
                bf16_t* rowp = O + (size_t)r * 1024 + col0;
#pragma unroll
                for (int bj = 0; bj < 2; ++bj) { const f32x4 v0 = acc[ai][bj][m][0] * sc, v1 = acc[ai][bj][m][1] * sc;
                    u32x4 w; w.x = pk2(v0[0], v0[1]); w.y = pk2(v0[2], v0[3]); w.z = pk2(v1[0], v1[1]); w.w = pk2(v1[2], v1[3]);
                    *(u32x4*)(rowp + bj * HALF) = w; }
                asm volatile("" ::: "memory"); __builtin_amdgcn_sched_barrier(0); }
    }
};
struct EpiKT {
    static constexpr bool PERM = true;
    bf16_t* Kf; bf16_t* Kb; const float* rc; const float* rs; const float* rd;
    __device__ __forceinline__ void operator()(const f32x4 (&acc)[2][2][4][2], const Unit& u, int wr, int wc, int fr, int fq) const {
        const int head = u.pm; const float l2f = rd[head], l2b = rd[4 + head];
#pragma unroll
        for (int bj = 0; bj < 2; ++bj)
#pragma unroll
            for (int n = 0; n < 2; ++n) { const int tok0 = u.pn * BM + bj * HALF + wc * 32 + 8 * fq + 4 * n;
                float ff[4], fb[4]; int tof[4];
#pragma unroll
                for (int j = 0; j < 4; ++j) { const int t = tok0 + j, pos = (t < NPROMPT) ? (t & 8191) : ((t - NPROMPT) & 4095), ic = t & (RC - 1);
                    ff[j] = __builtin_amdgcn_exp2f(l2f * (float)(RC - 1 - ic)); fb[j] = __builtin_amdgcn_exp2f(l2b * (float)ic); tof[j] = pos * 128; }
#pragma unroll
                for (int m = 0; m < 4; ++m) { const int il = wr * 64 + m * 16 + fr;
                    const f32x4 x1 = acc[0][bj][m][n], x2 = acc[1][bj][m][n]; float y1[4], y2[4];
#pragma unroll
                    for (int j = 0; j < 4; ++j) { const float c = rc[tof[j] + il], s = rs[tof[j] + il]; y1[j] = x1[j] * c - x2[j] * s; y2[j] = x1[j] * s + x2[j] * c; }
                    const size_t o1 = (size_t)(head * 256 + il) * NT + tok0, o2 = o1 + (size_t)128 * NT;
                    u32x2 w;
                    w.x = pk2(y1[0] * ff[0], y1[1] * ff[1]); w.y = pk2(y1[2] * ff[2], y1[3] * ff[3]); *(u32x2*)(Kf + o1) = w;
                    w.x = pk2(y2[0] * ff[0], y2[1] * ff[1]); w.y = pk2(y2[2] * ff[2], y2[3] * ff[3]); *(u32x2*)(Kf + o2) = w;
                    w.x = pk2(y1[0] * fb[0], y1[1] * fb[1]); w.y = pk2(y1[2] * fb[2], y1[3] * fb[3]); *(u32x2*)(Kb + o1) = w;
                    w.x = pk2(y2[0] * fb[0], y2[1] * fb[1]); w.y = pk2(y2[2] * fb[2], y2[3] * fb[3]); *(u32x2*)(Kb + o2) = w;
                    asm volatile("" ::: "memory"); __builtin_amdgcn_sched_barrier(0); }
            }
    }
};

template <class Epi, class Sched>
__device__ __forceinline__ void gemm_phase(LAS unsigned char* lds, const int tid, const int K, const int lda, const int ldb, const Sched& S, const Epi& E) {
    const int wid = __builtin_amdgcn_readfirstlane(tid >> 6), lane = tid & 63, wr = wid >> 2, wc = wid & 3, fr = lane & 15, fq = lane >> 4;
    const int nt = K / BK;
    unsigned voffA[2], voffB[2];
#pragma unroll
    for (int i = 0; i < 2; ++i) { int R, C; stage_rc(tid * 16 + i * 8192, R, C); const int Rb = Epi::PERM ? ((R & ~31) + perm32(R & 31)) : R;
        voffA[i] = (unsigned)(R * lda + C) * 2u; voffB[i] = (unsigned)(Rb * ldb + C) * 2u; }
    const size_t kstep = (size_t)(BK * 2);
    const size_t hstepA = (size_t)HALF * lda * 2, hstepB = (size_t)HALF * ldb * 2;
    const unsigned ldsw = (unsigned)wid * 1024u;
    const int aoff = lds_byte(wr * 64 + fr, fq * 8), boff = lds_byte(wc * 32 + fr, fq * 8);
#define PG8_SA(b, h) (((b) * 2 + (h)) * HTB)
#define PG8_SB(b, h) ((4 + (b) * 2 + (h)) * HTB)
#define PG8_STAGE(bufoff, gbase, voff) do { _Pragma("unroll") for (int _i = 0; _i < 2; ++_i) \
        __builtin_amdgcn_global_load_lds((const unsigned*)((const char*)(gbase) + (voff)[_i]), (LAS unsigned*)(lds + (bufoff) + ldsw + _i * 8192), 16, 0, 0); } while (0)
#define PG8_LDA(dst, b, h) do { _Pragma("unroll") for (int m = 0; m < 4; ++m) _Pragma("unroll") for (int k = 0; k < 2; ++k) dst[m][k] = *(const LAS bf16x8*)(lds + PG8_SA(b, h) + aoff + m * 2048 + k * 1024); } while (0)
#define PG8_LDB(dst, b, h) do { _Pragma("unroll") for (int n = 0; n < 2; ++n) _Pragma("unroll") for (int k = 0; k < 2; ++k) dst[n][k] = *(const LAS bf16x8*)(lds + PG8_SB(b, h) + boff + n * 2048 + k * 1024); } while (0)
#define PG8_MMA(ai, bj, At, Bt) do { __builtin_amdgcn_s_setprio(1); _Pragma("unroll") for (int m = 0; m < 4; ++m) _Pragma("unroll") for (int n = 0; n < 2; ++n) _Pragma("unroll") for (int k = 0; k < 2; ++k) \
        acc[ai][bj][m][n] = __builtin_amdgcn_mfma_f32_16x16x32_bf16(Bt[n][k], At[m][k], acc[ai][bj][m][n], 0, 0, 0); __builtin_amdgcn_s_setprio(0); } while (0)
#define PG8_WAIT_V(n) asm volatile("s_waitcnt vmcnt(" #n ")" ::: "memory")
#define PG8_WAIT_L(n) asm volatile("s_waitcnt lgkmcnt(" #n ")" ::: "memory")
#define PG8_BAR __builtin_amdgcn_s_barrier()
#define PG8_SCHED __builtin_amdgcn_sched_barrier(0)
    Unit cur, nxt; int ui = 0;
    if (!S.next(0, cur)) return;
    f32x4 acc[2][2][4][2];
#pragma unroll
    for (int a = 0; a < 2; ++a)
#pragma unroll
        for (int b = 0; b < 2; ++b)
#pragma unroll
            for (int m = 0; m < 4; ++m)
#pragma unroll
                for (int n = 0; n < 2; ++n) acc[a][b][m][n] = (f32x4){0.f, 0.f, 0.f, 0.f};
    bf16x8 At[4][2], B0[2][2], B1[2][2];
    const char* cA = S.a_ptr(cur); const char* cB = S.b_ptr(cur);
    PG8_STAGE(PG8_SB(0, 0), cB, voffB); PG8_STAGE(PG8_SA(0, 0), cA, voffA); PG8_STAGE(PG8_SB(0, 1), cB + hstepB, voffB); PG8_STAGE(PG8_SA(0, 1), cA + hstepA, voffA);
    if (wr == 1) PG8_BAR;
    PG8_WAIT_V(4); PG8_BAR;
    PG8_STAGE(PG8_SB(1, 0), cB + kstep, voffB); PG8_STAGE(PG8_SA(1, 0), cA + kstep, voffA); PG8_STAGE(PG8_SB(1, 1), cB + hstepB + kstep, voffB);
    PG8_WAIT_V(6); PG8_BAR;
    for (;;) {
        const bool has_next = S.next(ui + 1, nxt);
        const char* nA = has_next ? S.a_ptr(nxt) : cA; const char* nB = has_next ? S.b_ptr(nxt) : cB;
        for (int t = 0; t < nt; t += 2) {
            const bool last = (t == nt - 2);
            const char* a1 = cA + (size_t)(t + 1) * kstep;
            const char* a2 = last ? nA : cA + (size_t)(t + 2) * kstep; const char* b2 = last ? nB : cB + (size_t)(t + 2) * kstep;
            const char* a3 = a2 + kstep; const char* b3 = b2 + kstep;
            PG8_LDB(B0, 0, 0); PG8_SCHED; PG8_LDA(At, 0, 0); PG8_STAGE(PG8_SA(1, 1), a1 + hstepA, voffA);
            PG8_WAIT_L(8); PG8_BAR; PG8_WAIT_L(0); PG8_MMA(0, 0, At, B0); PG8_BAR; PG8_SCHED;
            PG8_LDB(B1, 0, 1); PG8_STAGE(PG8_SB(0, 0), b2, voffB);
            PG8_BAR; PG8_WAIT_L(0); PG8_MMA(0, 1, At, B1); PG8_BAR;
            PG8_LDA(At, 0, 1); PG8_STAGE(PG8_SA(0, 0), a2, voffA);
            PG8_BAR; PG8_WAIT_L(0); PG8_MMA(1, 0, At, B0); PG8_BAR; PG8_SCHED;
            PG8_STAGE(PG8_SB(0, 1), b2 + hstepB, voffB);
            PG8_WAIT_V(6); PG8_BAR; PG8_MMA(1, 1, At, B1); PG8_BAR;
            PG8_LDB(B0, 1, 0); PG8_SCHED; PG8_LDA(At, 1, 0); PG8_STAGE(PG8_SA(0, 1), a2 + hstepA, voffA);
            PG8_WAIT_L(8); PG8_BAR; PG8_WAIT_L(0); PG8_MMA(0, 0, At, B0); PG8_BAR; PG8_SCHED;
            PG8_LDB(B1, 1, 1); PG8_STAGE(PG8_SB(1, 0), b3, voffB);
            PG8_BAR; PG8_WAIT_L(0); PG8_MMA(0, 1, At, B1); PG8_BAR;
            PG8_LDA(At, 1, 1); PG8_STAGE(PG8_SA(1, 0), a3, voffA);
            PG8_BAR; PG8_WAIT_L(0); PG8_MMA(1, 0, At, B0); PG8_BAR; PG8_SCHED;
            PG8_STAGE(PG8_SB(1, 1), b3 + hstepB, voffB);
            PG8_WAIT_V(6); PG8_BAR; PG8_MMA(1, 1, At, B1); PG8_BAR;
        }
        E(acc, cur, wr, wc, fr, fq);
        if (!has_next) break;
#pragma unroll
        for (int a = 0; a < 2; ++a)
#pragma unroll
            for (int b = 0; b < 2; ++b)
#pragma unroll
                for (int m = 0; m < 4; ++m)
#pragma unroll
                    for (int n = 0; n < 2; ++n) acc[a][b][m][n] = (f32x4){0.f, 0.f, 0.f, 0.f};
        cur = nxt; cA = nA; cB = nB; ++ui;
    }
    PG8_WAIT_V(0);
    if (wr == 0) PG8_BAR;
    PG8_BAR;
#undef PG8_SA
#undef PG8_SB
#undef PG8_STAGE
#undef PG8_LDA
#undef PG8_LDB
#undef PG8_MMA
#undef PG8_WAIT_V
#undef PG8_WAIT_L
#undef PG8_BAR
#undef PG8_SCHED
}
}

struct MapId { int row_off; __device__ __forceinline__ int operator()(int n, float& sc) const { sc = 1.0f; return n + row_off; } };
struct MapOdd { __device__ __forceinline__ int operator()(int n, float& sc) const {
    const int seg = n >> 10, w = n & 1023; sc = (seg == 1) ? 0.0625f : (seg == 4 ? 0.125f : 1.0f);
    const int dseg = (seg == 0) ? 0 : (seg == 1) ? 1 : (seg == 2) ? 5 : (seg == 3) ? 2 : (seg == 4) ? 3 : (seg == 5) ? 4 : 6;
    return dseg * 1024 + w; } };
struct MapGU { int up; __device__ __forceinline__ int operator()(int n, float& sc) const { sc = 1.0f; return (n >> 4) * 32 + (n & 15) + up * 16; } };

template <class Map>
__device__ __forceinline__ void wt_item(const float* W, int K, int N, bf16_t* WT, const Map& map, LAS float* scr, int item, int lane) {
    const int nblk = N / 32, kb = item / nblk, nb = item % nblk, k0 = 64 * kb, n0 = 32 * nb;
#pragma unroll 8
    for (int i = 0; i < 32; ++i) { const int kk = 2 * i + (lane >> 5); scr[kk * 33 + (lane & 31)] = W[(size_t)(k0 + kk) * N + n0 + (lane & 31)]; }
    LDS_WAIT(); asm volatile("" ::: "memory");
    const int c = lane & 7;
#pragma unroll
    for (int j = 0; j < 4; ++j) { const int n = (lane >> 3) + 8 * j; const LAS float* s = scr + (8 * c) * 33 + n; float sc; const int drow = map(n0 + n, sc);
        u32x4 o; o.x = pk2(s[0 * 33] * sc, s[1 * 33] * sc); o.y = pk2(s[2 * 33] * sc, s[3 * 33] * sc); o.z = pk2(s[4 * 33] * sc, s[5 * 33] * sc); o.w = pk2(s[6 * 33] * sc, s[7 * 33] * sc);
        *(u32x4*)(WT + (size_t)drow * K + k0 + 8 * c) = o; }
    LDS_WAIT(); asm volatile("" ::: "memory");
}
template <class Map>
__device__ __forceinline__ void wt_matrix(const float* W, int K, int N, bf16_t* WT, const Map& map, LAS float* scr, int gw, int NGW, int lane) {
    const int nitems = (K / 64) * (N / 32);
    for (int it = gw; it < nitems; it += NGW) wt_item(W, K, N, WT, map, scr, it, lane);
}

__device__ __forceinline__ void unpack8(const u32x4 w, float (&v)[8]) { v[0] = bf_lo(w.x); v[1] = bf_hi(w.x); v[2] = bf_lo(w.y); v[3] = bf_hi(w.y); v[4] = bf_lo(w.z); v[5] = bf_hi(w.z); v[6] = bf_lo(w.w); v[7] = bf_hi(w.w); }
__device__ __forceinline__ u32x4 pack8(const float (&v)[8]) { u32x4 w; w.x = pk2(v[0], v[1]); w.y = pk2(v[2], v[3]); w.z = pk2(v[4], v[5]); w.w = pk2(v[6], v[7]); return w; }
template <int MODE>
__device__ __forceinline__ void nrn_phase(const float* xin_p, const float* xin_s, bf16_t* xb, float* xout, const bf16_t* tmp, const float* gA, const float* gB, bf16_t* h, int gw, int NGW, int lane) {
    constexpr int R = 2;
    for (int row0 = gw; row0 < NT; row0 += R * NGW) {
        float xv[R][4][8], tv[R][4][8];
#pragma unroll
        for (int q = 0; q < R; ++q) { const int row = row0 + q * NGW; if (row < NT) {
            if (MODE == 0) { const float* src = row < NPROMPT ? xin_p + (size_t)row * D : xin_s + (size_t)(row - NPROMPT) * D;
#pragma unroll
                for (int j = 0; j < 4; ++j) { const f32x4 a = *(const f32x4*)(src + 8 * lane + 512 * j), b = *(const f32x4*)(src + 8 * lane + 512 * j + 4);
                    xv[q][j][0] = a[0]; xv[q][j][1] = a[1]; xv[q][j][2] = a[2]; xv[q][j][3] = a[3]; xv[q][j][4] = b[0]; xv[q][j][5] = b[1]; xv[q][j][6] = b[2]; xv[q][j][7] = b[3]; } }
            else {
#pragma unroll
                for (int j = 0; j < 4; ++j) { unpack8(*(const u32x4*)(xb + (size_t)row * D + 8 * lane + 512 * j), xv[q][j]); unpack8(*(const u32x4*)(tmp + (size_t)row * D + 8 * lane + 512 * j), tv[q][j]); } } } }
#pragma unroll
        for (int q = 0; q < R; ++q) { const int row = row0 + q * NGW; if (row < NT) {
            if (MODE != 0) {
                float ss = 0.f;
#pragma unroll
                for (int j = 0; j < 4; ++j)
#pragma unroll
                    for (int e = 0; e < 8; ++e) ss += tv[q][j][e] * tv[q][j][e];
                const float rstd = 1.0f / sqrtf(wave_sum(ss) * (1.0f / D) + RMS_EPS);
#pragma unroll
                for (int j = 0; j < 4; ++j) { const f32x4 ga = *(const f32x4*)(gA + 8 * lane + 512 * j), gb = *(const f32x4*)(gA + 8 * lane + 512 * j + 4);
                    const float g8[8] = {ga[0], ga[1], ga[2], ga[3], gb[0], gb[1], gb[2], gb[3]};
#pragma unroll
                    for (int e = 0; e < 8; ++e) xv[q][j][e] += tv[q][j][e] * rstd * g8[e]; }
            }
            if (MODE == 2) {
#pragma unroll
                for (int j = 0; j < 4; ++j) { float* dst = xout + (size_t)row * D + 8 * lane + 512 * j;
                    *(f32x4*)dst = (f32x4){xv[q][j][0], xv[q][j][1], xv[q][j][2], xv[q][j][3]}; *(f32x4*)(dst + 4) = (f32x4){xv[q][j][4], xv[q][j][5], xv[q][j][6], xv[q][j][7]}; }
            } else {
                float ss = 0.f;
#pragma unroll
                for (int j = 0; j < 4; ++j) { *(u32x4*)(xb + (size_t)row * D + 8 * lane + 512 * j) = pack8(xv[q][j]);
#pragma unroll
                    for (int e = 0; e < 8; ++e) ss += xv[q][j][e] * xv[q][j][e]; }
                const float rstd = 1.0f / sqrtf(wave_sum(ss) * (1.0f / D) + RMS_EPS);
#pragma unroll
                for (int j = 0; j < 4; ++j) { const f32x4 ga = *(const f32x4*)(gB + 8 * lane + 512 * j), gb = *(const f32x4*)(gB + 8 * lane + 512 * j + 4);
                    const float g8[8] = {ga[0], ga[1], ga[2], ga[3], gb[0], gb[1], gb[2], gb[3]}; float o[8];
#pragma unroll
                    for (int e = 0; e < 8; ++e) o[e] = xv[q][j][e] * rstd * g8[e];
                    *(u32x4*)(h + (size_t)row * D + 8 * lane + 512 * j) = pack8(o); }
            } } }
    }
}

__device__ __forceinline__ void memnorm_phase(const float* mem_p, const float* mem_s, const float* g, bf16_t* memn, int gw, int NGW, int lane) {
    for (int row = gw; row < NMEMTOK; row += NGW) {
        const float* src = row < 1024 ? mem_p + (size_t)row * D : mem_s + (size_t)(row - 1024) * D;
        float xv[4][8]; float ss = 0.f;
#pragma unroll
        for (int j = 0; j < 4; ++j) { const f32x4 a = *(const f32x4*)(src + 8 * lane + 512 * j), b = *(const f32x4*)(src + 8 * lane + 512 * j + 4);
            xv[j][0] = a[0]; xv[j][1] = a[1]; xv[j][2] = a[2]; xv[j][3] = a[3]; xv[j][4] = b[0]; xv[j][5] = b[1]; xv[j][6] = b[2]; xv[j][7] = b[3];
#pragma unroll
            for (int e = 0; e < 8; ++e) ss += xv[j][e] * xv[j][e]; }
        const float rstd = 1.0f / sqrtf(wave_sum(ss) * (1.0f / D) + RMS_EPS);
#pragma unroll
        for (int j = 0; j < 4; ++j) { const f32x4 ga = *(const f32x4*)(g + 8 * lane + 512 * j), gb = *(const f32x4*)(g + 8 * lane + 512 * j + 4);
            u32x4 w; w.x = pk2(xv[j][0] * rstd * ga[0], xv[j][1] * rstd * ga[1]); w.y = pk2(xv[j][2] * rstd * ga[2], xv[j][3] * rstd * ga[3]);
            w.z = pk2(xv[j][4] * rstd * gb[0], xv[j][5] * rstd * gb[1]); w.w = pk2(xv[j][6] * rstd * gb[2], xv[j][7] * rstd * gb[3]);
            *(u32x4*)(memn + (size_t)row * D + 8 * lane + 512 * j) = w; }
    }
}

__device__ __forceinline__ void softmax_phase(const float* S, bf16_t* P, int gw, int NGW, int lane) {
    for (int row0 = gw; row0 < NT; row0 += 2 * NGW) {
        f32x4 v[2][4];
#pragma unroll
        for (int q = 0; q < 2; ++q) { const int row = row0 + q * NGW; if (row < NT) {
#pragma unroll
            for (int hd = 0; hd < 4; ++hd) v[q][hd] = *(const f32x4*)(S + (size_t)row * 1024 + hd * 256 + 4 * lane); } }
#pragma unroll
        for (int q = 0; q < 2; ++q) { const int row = row0 + q * NGW; if (row < NT) {
#pragma unroll
            for (int hd = 0; hd < 4; ++hd) { const f32x4 x = v[q][hd];
                const float mx = wave_max(fmaxf(fmaxf(x[0], x[1]), fmaxf(x[2], x[3])));
                const float e0 = __expf(x[0] - mx), e1 = __expf(x[1] - mx), e2 = __expf(x[2] - mx), e3 = __expf(x[3] - mx);
                const float inv = 1.0f / wave_sum((e0 + e1) + (e2 + e3));
                u32x2 w; w.x = pk2(e0 * inv, e1 * inv); w.y = pk2(e2 * inv, e3 * inv);
                *(u32x2*)(P + (size_t)row * 1024 + hd * 256 + 4 * lane) = w; } } }
    }
}

__device__ __forceinline__ void tables_phase(f32x2* TW, float* rc, float* rs, int gtid, int NGT) {
    for (int k = gtid; k < 8192; k += NGT) { const float a = (float)k * (1.0f / 8192.0f); TW[k] = MK2(cospif(a), -sinpif(a)); }
    for (int idx = gtid; idx < 8192 * 128; idx += NGT) { const int pos = idx >> 7, i = idx & 127;
        const double inv = pow(10000.0, -(double)i / 128.0), ang = (double)pos * inv; rc[idx] = (float)cos(ang); rs[idx] = (float)sin(ang); }
}

__device__ __forceinline__ void hyena_hid_phase(const float* w1, const float* b1, const float* freq, const float* w2, const float* b2, bf16_t* hid2, int gw, int NGW, int lane) {
    for (int t = gw; t < 8192 + 4096; t += NGW) {
        const int L = t < 8192 ? 8192 : 4096, l = t < 8192 ? t : t - 8192;
        const double tn = (double)l / (double)L;
        float feat = 0.f;
        if (lane == 0) feat = (float)tn;
        else if (lane <= 16) feat = (float)cos(6.283185307179586476925 * tn * (double)lane);
        else if (lane <= 32) feat = (float)sin(6.283185307179586476925 * tn * (double)(lane - 16));
        float a = b1[lane];
        for (int e = 0; e < 33; ++e) a += __shfl(feat, e) * w1[e * 64 + lane];
        const float h1 = sinf(freq[lane] * a);
        float c = b2[lane];
        for (int i = 0; i < 64; ++i) c += __shfl(h1, i) * w2[i * 64 + lane];
        hid2[(size_t)t * 64 + lane] = (bf16_t)f2bf(sinf(freq[64 + lane] * c));
    }
}

__device__ __forceinline__ void s5_tables_phase(const float* a_re, const float* a_im, const float* log_dt, const float* b_re, const float* b_im, const float* c_re, const float* c_im, f32x2* lamb, bf16_t* bua, bf16_t* cmb, int gtid, int NGT) {
    for (int idx = gtid; idx < 64 * 4 * 64; idx += NGT) { const int lane = idx & 63, s = (idx >> 6) & 3, dg = idx >> 8, i = lane & 15, kq = lane >> 4; unsigned w[4];
#pragma unroll
        for (int j2 = 0; j2 < 4; ++j2) { float v[2];
#pragma unroll
            for (int e = 0; e < 2; ++e) { const int k = 32 * s + 8 * kq + 2 * j2 + e; v[e] = (k < 64) ? c_re[((size_t)dg * 16 + i) * 64 + k] : -c_im[((size_t)dg * 16 + i) * 64 + (k - 64)]; }
            w[j2] = f2bf(v[0]) | (f2bf(v[1]) << 16); }
        *(u32x4*)(cmb + (size_t)idx * 8) = (u32x4){w[0], w[1], w[2], w[3]}; }
    for (int idx = gtid; idx < 64 * 8 * 64; idx += NGT) { const int lane = idx & 63, ti = (idx >> 6) & 7, dg = idx >> 9, comp = 16 * ti + (lane & 15), p = comp >> 1, part = comp & 1, kq = lane >> 4, sidx = dg * 64 + p;
        const double ar = a_re[sidx], ai = a_im[sidx], dt = exp((double)log_dt[dg]);
        const double er = exp(ar * dt), lr = er * cos(ai * dt), li = er * sin(ai * dt);
        const double nr = lr - 1.0, ni = li, den = ar * ar + ai * ai;
        const double cr = (nr * ar + ni * ai) / den, ci = (ni * ar - nr * ai) / den;
        if (part == 0 && kq == 0) lamb[sidx] = MK2((float)lr, (float)li);
        unsigned w[4];
#pragma unroll
        for (int j2 = 0; j2 < 4; ++j2) { float v[2];
#pragma unroll
            for (int e = 0; e < 2; ++e) { const int ch = 8 * kq + 2 * j2 + e; float val = 0.f;
                if (kq < 2) { const double br = b_re[(size_t)sidx * 16 + ch], bi = b_im[(size_t)sidx * 16 + ch]; val = part ? (float)(cr * bi + ci * br) : (float)(cr * br - ci * bi); }
                v[e] = val; }
            w[j2] = f2bf(v[0]) | (f2bf(v[1]) << 16); }
        *(u32x4*)(bua + (size_t)idx * 8) = (u32x4){w[0], w[1], w[2], w[3]}; }
}

__device__ __forceinline__ int PD(int i) { return i + (i >> 4); }
__device__ __forceinline__ f32x2 cmul(f32x2 a, f32x2 b) { f32x2 t, d;
    asm("v_pk_mul_f32 %0, %1, %2 op_sel:[0,0] op_sel_hi:[0,1]" : "=v"(t) : "v"(a), "v"(b));
    asm("v_pk_fma_f32 %0, %1, %2, %3 op_sel:[1,1,0] op_sel_hi:[1,0,1] neg_lo:[0,1,0]" : "=v"(d) : "v"(a), "v"(b), "v"(t));
    return d; }
__device__ __forceinline__ f32x2 cmulc(f32x2 a, f32x2 b) { f32x2 t, d;
    asm("v_pk_mul_f32 %0, %1, %2 op_sel:[0,0] op_sel_hi:[0,1]" : "=v"(t) : "v"(a), "v"(b));
    asm("v_pk_fma_f32 %0, %1, %2, %3 op_sel:[1,1,0] op_sel_hi:[1,0,1] neg_hi:[0,0,1]" : "=v"(d) : "v"(a), "v"(b), "v"(t));
    return d; }

template <int LOGN, int A, int R, int INV, int PRUNE = 0>
__device__ __forceinline__ void fft_pass(LAS f32x2* x, const f32x2* TW, int tid) {
    asm volatile("" : "+v"(tid));
    constexpr int N = 1 << LOGN, RAD = 1 << R, LOGSB = A - R + 1, SB = 1 << LOGSB;
    constexpr float C16[16] = {1.0f, 0.98078528040323043f, 0.92387953251128674f, 0.83146961230254524f, 0.70710678118654752f, 0.55557023301960218f, 0.38268343236508977f, 0.19509032201612825f,
                               0.0f, -0.19509032201612825f, -0.38268343236508977f, -0.55557023301960218f, -0.70710678118654752f, -0.83146961230254524f, -0.92387953251128674f, -0.98078528040323043f};
    constexpr float S16[16] = {0.0f, -0.19509032201612825f, -0.38268343236508977f, -0.55557023301960218f, -0.70710678118654752f, -0.83146961230254524f, -0.92387953251128674f, -0.98078528040323043f,
                               -1.0f, -0.98078528040323043f, -0.92387953251128674f, -0.83146961230254524f, -0.70710678118654752f, -0.55557023301960218f, -0.38268343236508977f, -0.19509032201612825f};
#pragma unroll 1
    for (int g = tid; g < N / RAD; g += NWG_THREADS) {
        const int lo = g & (SB - 1), hi = g >> LOGSB;
        const int base = (hi << (A + 1)) | lo;
        static_assert(SB % 16 == 0 || (SB == 1 && RAD <= 16), "padded-index offsets"); static_assert(RAD <= 32, "twiddle table");
        constexpr int PDS = (SB >= 16) ? SB + SB / 16 : SB; const int pdb = PD(base);
        f32x2 e[RAD];
#pragma unroll
        for (int j = 0; j < RAD; ++j) { if (PRUNE && !INV && j >= RAD / 2) e[j] = MK2(0.f, 0.f); else e[j] = x[pdb + j * PDS]; }
#pragma unroll
        for (int qq = 0; qq < R; ++qq) {
            const int q = INV ? (R - 1 - qq) : qq;
            const int half = RAD >> (q + 1);
            const float rev_ = (float)(lo << (LOGN - 1 - A + q)) * (1.0f / (float)N);
            f32x2 wq = MK2(__builtin_amdgcn_cosf(rev_), -__builtin_amdgcn_sinf(rev_));
            asm("s_nop 1" : "+v"(wq));
#pragma unroll
            for (int j = 0; j < RAD; ++j) {
                if (j & half) continue;
                const int m16 = ((j & (half - 1)) * 16) / half;
                const f32x2 w = (m16 == 0) ? wq : cmul(wq, MK2(C16[m16], S16[m16]));
                if (!INV) { if (PRUNE && q == 0) { e[j + half] = cmul(e[j], w); } else { const f32x2 a = e[j], b = e[j + half]; e[j] = a + b; e[j + half] = cmul(a - b, w); } }
                else { const f32x2 a = e[j], b = cmulc(e[j + half], w); e[j] = a + b; e[j + half] = a - b; }
            }
        }
#pragma unroll
        for (int j = 0; j < RAD; ++j) { if (PRUNE && INV && j >= RAD / 2) continue; x[pdb + j * PDS] = e[j]; }
    }
    __syncthreads();
}
template <int LOGN, int PRUNE = 0> __device__ __forceinline__ void fft_fwd(LAS f32x2* x, const f32x2* TW, int tid) {
    if constexpr (LOGN == 14) { fft_pass<LOGN, 13, 5, 0, PRUNE>(x, TW, tid); fft_pass<LOGN, 8, 5, 0>(x, TW, tid); fft_pass<LOGN, 3, 4, 0>(x, TW, tid); }
    else { static_assert(LOGN == 13, "pass plan"); fft_pass<LOGN, 12, 5, 0, PRUNE>(x, TW, tid); fft_pass<LOGN, 7, 4, 0>(x, TW, tid); fft_pass<LOGN, 3, 4, 0>(x, TW, tid); }
}
template <int LOGN, int PRUNE = 0> __device__ __forceinline__ void fft_inv(LAS f32x2* x, const f32x2* TW, int tid) {
    if constexpr (LOGN == 14) { fft_pass<LOGN, 3, 4, 1>(x, TW, tid); fft_pass<LOGN, 8, 5, 1>(x, TW, tid); fft_pass<LOGN, 13, 5, 1, PRUNE>(x, TW, tid); }
    else { fft_pass<LOGN, 3, 4, 1>(x, TW, tid); fft_pass<LOGN, 7, 4, 1>(x, TW, tid); fft_pass<LOGN, 12, 5, 1, PRUNE>(x, TW, tid); }
}
template <int LOGN> __device__ __forceinline__ int brev(int p) { return (int)(__brev((unsigned)p) >> (32 - LOGN)); }

constexpr int SPEC_STRIDE = 8200;

template <int LOGN>
__device__ __forceinline__ void hy_pointwise(LAS f32x2* x, const f32x4* spec, int tid) {
    asm volatile("" : "+v"(tid));
    constexpr int N = 1 << LOGN;
#pragma unroll 2
    for (int m = tid; m < N / 2; m += NWG_THREADS) {
        const int p = 2 * m, k = brev<LOGN>(p), pm = brev<LOGN>((N - k) & (N - 1));
        const f32x2 Zk = x[PD(p)], Zm = x[PD(pm)]; const f32x4 H = spec[m];
        const f32x2 A2 = MK2(Zk.x + Zm.x, Zk.y - Zm.y), B2 = MK2(Zk.x - Zm.x, Zk.y + Zm.y);
        const f32x2 P = cmul(A2, MK2(H.x, H.y)), W = cmul(B2, MK2(H.z, H.w));
        x[PD(p)] = MK2(P.x + W.x, P.y + W.y);
        if (pm != p) x[PD(pm)] = MK2(P.x - W.x, W.y - P.y);
    }
    if (tid == 0) { const f32x2 Z = x[PD(1)]; const f32x4 H = spec[N / 2]; x[PD(1)] = MK2(Z.x * H.x, Z.y * H.z); }
    __syncthreads();
}

struct HyArgs {
    const bf16_t* pT;
    const float* short_w;
    const float* short_b;
    const bf16_t* hid2;
    const float* w3;
    const float* skip;
    const f32x2* TW;
    bf16_t* z2;
};
typedef __amdgpu_buffer_rsrc_t rsrc_t;
__device__ __forceinline__ rsrc_t hy_rsrc(const bf16_t* prow, int L) { return __builtin_amdgcn_make_buffer_rsrc((void*)prow, 0, L * 2, 0x00020000); }
__device__ __forceinline__ void hy_sc8(rsrc_t r, int l0, const float* short_w, const float* short_b, int row, float (&o)[8]) {
    asm volatile("" : "+s"(row));
    const float sw[4] = {short_w[row], short_w[4608 + row], short_w[2 * 4608 + row], short_b[row]};
    const int bo = l0 * 2;
    const u32x4 c = __builtin_bit_cast(u32x4, __builtin_amdgcn_raw_buffer_load_b128(r, bo, 0, 0));
    float v[10];
    v[1] = bf_lo(c.x); v[2] = bf_hi(c.x); v[3] = bf_lo(c.y); v[4] = bf_hi(c.y); v[5] = bf_lo(c.z); v[6] = bf_hi(c.z); v[7] = bf_lo(c.w); v[8] = bf_hi(c.w);
    v[0] = bf1((bf16_t)__builtin_amdgcn_raw_buffer_load_b16(r, bo - 2, 0, 0)); v[9] = bf1((bf16_t)__builtin_amdgcn_raw_buffer_load_b16(r, bo + 16, 0, 0));
#pragma unroll
    for (int e = 0; e < 8; ++e) o[e] = sw[0] * v[e] + sw[1] * v[e + 1] + sw[2] * v[e + 2] + sw[3];
}

template <int LOGN>
__device__ __forceinline__ void hyena_task(LAS unsigned char* lds, const HyArgs& H, int ch, int tokbase, int nbatch, f32x4* spec, int tid) {
    constexpr int N = 1 << LOGN, L = N / 2;
    asm volatile("" : "+v"(tid));
    LAS f32x2* x = (LAS f32x2*)lds;
    LAS f32x4* w3s = (LAS f32x4*)(lds + 139264);
    const bf16_t* hid = H.hid2 + (LOGN == 14 ? 0 : (size_t)8192 * 64);
    const float la = -3.0701134573253944f, lb = -15.350567286626972f;
    const float dela = fabsf(la + (lb - la) * ((float)ch / 1535.0f)), delb = fabsf(la + (lb - la) * ((float)(ch + 1) / 1535.0f));
    for (int o = 0; o < 2; ++o) {
        if (tid < 256) { const int j = tid >> 2, q = tid & 3; ((LAS float*)w3s)[tid] = H.w3[(size_t)j * 6144 + (o * 2 + (q >> 1)) * 1536 + ch + (q & 1)]; }
        __syncthreads();
        { const int lane = tid & 63, wave = __builtin_amdgcn_readfirstlane(tid >> 6), n = lane & 15, kq = lane >> 4;
          bf16x8 Wf[2];
#pragma unroll
          for (int kb = 0; kb < 2; ++kb) { u32x4 w = (u32x4){0u, 0u, 0u, 0u};
              if (n < 4) { float f[8];
#pragma unroll
                  for (int i = 0; i < 8; ++i) f[i] = ((const LAS float*)w3s)[(32 * kb + 8 * kq + i) * 4 + n];
                  w.x = pk2(f[0], f[1]); w.y = pk2(f[2], f[3]); w.z = pk2(f[4], f[5]); w.w = pk2(f[6], f[7]); }
              Wf[kb] = __builtin_bit_cast(bf16x8, w); }
#pragma unroll 4
          for (int lt = wave; lt < L / 16; lt += 8) {
              const int l = lt * 16 + n;
              const bf16x8 h0 = *(const bf16x8*)(hid + (size_t)l * 64 + 8 * kq), h1 = *(const bf16x8*)(hid + (size_t)l * 64 + 32 + 8 * kq);
              f32x4 acc = __builtin_amdgcn_mfma_f32_16x16x32_bf16(Wf[0], h0, (f32x4){0.f, 0.f, 0.f, 0.f}, 0, 0, 0);
              acc = __builtin_amdgcn_mfma_f32_16x16x32_bf16(Wf[1], h1, acc, 0, 0, 0);
              if (kq == 0) {
                  const float tn = (float)l / (float)L; const float da = expf(-tn * dela), db = expf(-tn * delb);
                  x[PD(l)] = MK2(acc[0] * da, acc[1] * db);
                  if (l >= 1) x[PD(N - l)] = MK2(acc[2] * da, acc[3] * db);
                  if (l == 0) x[PD(L)] = MK2(0.f, 0.f); }
          } }
        __syncthreads();
        fft_fwd<LOGN>(x, H.TW, tid);
        f32x4* so = spec + (size_t)o * SPEC_STRIDE;
        const float sc = 1.0f / (4.0f * (float)N);
#pragma unroll 2
        for (int m = tid; m < N / 2; m += NWG_THREADS) {
            const int p = 2 * m, k = brev<LOGN>(p), pm = brev<LOGN>((N - k) & (N - 1));
            const f32x2 Gk = x[PD(p)], Gm = x[PD(pm)];
            so[m] = MK4((Gk.x + Gm.x) * sc, (Gk.y - Gm.y) * sc, (Gk.y + Gm.y) * sc, -(Gk.x - Gm.x) * sc);
        }
        if (tid == 0) { const f32x2 G = x[PD(1)]; so[N / 2] = MK4(G.x / (float)N, 0.f, G.y / (float)N, 0.f); }
        VM_WAIT(); __syncthreads();
    }
    constexpr int NG = L / 8 / NWG_THREADS;
    for (int b = 0; b < nbatch; ++b) {
        asm volatile("" : "+v"(tid));
        const size_t tok0 = (size_t)tokbase + (size_t)b * L;
        const rsrc_t rv_a = hy_rsrc(H.pT + (size_t)ch * NT + tok0, L), rv_b = hy_rsrc(H.pT + (size_t)(ch + 1) * NT + tok0, L);
        const rsrc_t r1_a = hy_rsrc(H.pT + (size_t)(1536 + ch) * NT + tok0, L), r1_b = hy_rsrc(H.pT + (size_t)(1536 + ch + 1) * NT + tok0, L);
        const rsrc_t rz_a = hy_rsrc(H.z2 + (size_t)ch * NT + tok0, L), rz_b = hy_rsrc(H.z2 + (size_t)(ch + 1) * NT + tok0, L);
        const rsrc_t r2_a = hy_rsrc(H.pT + (size_t)(3072 + ch) * NT + tok0, L), r2_b = hy_rsrc(H.pT + (size_t)(3072 + ch + 1) * NT + tok0, L);
#pragma unroll
        for (int i = 0; i < NG; ++i) { const int l0 = 8 * (tid + NWG_THREADS * i); float va[8], vb[8];
            hy_sc8(rv_a, l0, H.short_w, H.short_b, ch, va); hy_sc8(rv_b, l0, H.short_w, H.short_b, ch + 1, vb);
#pragma unroll
            for (int e = 0; e < 8; ++e) { x[PD(l0 + e)] = MK2(va[e], vb[e]); } }
        __syncthreads();
        fft_fwd<LOGN, 1>(x, H.TW, tid);
        hy_pointwise<LOGN>(x, spec, tid);
        fft_inv<LOGN, 1>(x, H.TW, tid);
        f32x4* z1s = spec + 2 * SPEC_STRIDE;
#pragma unroll
        for (int i = 0; i < NG; ++i) { const int l0 = 8 * (tid + NWG_THREADS * i); float va[8], vb[8], xa[8], xb[8], za[8], zb[8];
            hy_sc8(rv_a, l0, H.short_w, H.short_b, ch, va); hy_sc8(rv_b, l0, H.short_w, H.short_b, ch + 1, vb); hy_sc8(r1_a, l0, H.short_w, H.short_b, 1536 + ch, xa); hy_sc8(r1_b, l0, H.short_w, H.short_b, 1536 + ch + 1, xb);
            const float sk0a = H.skip[ch], sk0b = H.skip[ch + 1];
#pragma unroll
            for (int e = 0; e < 8; ++e) { const f32x2 y = x[PD(l0 + e)]; za[e] = xa[e] * (y.x + sk0a * va[e]); zb[e] = xb[e] * (y.y + sk0b * vb[e]); }
            f32x4* zp = z1s + (size_t)(i * NWG_THREADS + tid) * 4;
            zp[0] = MK4(za[0], za[1], za[2], za[3]); zp[1] = MK4(za[4], za[5], za[6], za[7]); zp[2] = MK4(zb[0], zb[1], zb[2], zb[3]); zp[3] = MK4(zb[4], zb[5], zb[6], zb[7]);
            __syncthreads();
#pragma unroll
            for (int e = 0; e < 8; ++e) { x[PD(l0 + e)] = MK2(za[e], zb[e]); } }
        __syncthreads();
        fft_fwd<LOGN, 1>(x, H.TW, tid);
        hy_pointwise<LOGN>(x, spec + SPEC_STRIDE, tid);
        fft_inv<LOGN, 1>(x, H.TW, tid);
#pragma unroll
        for (int i = 0; i < NG; ++i) { const int l0 = 8 * (tid + NWG_THREADS * i); float xa[8], xb[8], oa[8], ob[8];
            hy_sc8(r2_a, l0, H.short_w, H.short_b, 3072 + ch, xa); hy_sc8(r2_b, l0, H.short_w, H.short_b, 3072 + ch + 1, xb);
            const f32x4* zp = z1s + (size_t)(i * NWG_THREADS + tid) * 4; const f32x4 q0 = zp[0], q1 = zp[1], q2 = zp[2], q3 = zp[3];
            const float za[8] = {q0[0], q0[1], q0[2], q0[3], q1[0], q1[1], q1[2], q1[3]}, zb[8] = {q2[0], q2[1], q2[2], q2[3], q3[0], q3[1], q3[2], q3[3]};
            const float sk1a = H.skip[1536 + ch], sk1b = H.skip[1536 + ch + 1];
#pragma unroll
            for (int e = 0; e < 8; ++e) { const f32x2 y = x[PD(l0 + e)]; oa[e] = xa[e] * (y.x + sk1a * za[e]); ob[e] = xb[e] * (y.y + sk1b * zb[e]); }
            u32x4 wa, wb; wa.x = pk2(oa[0], oa[1]); wa.y = pk2(oa[2], oa[3]); wa.z = pk2(oa[4], oa[5]); wa.w = pk2(oa[6], oa[7]);
            wb.x = pk2(ob[0], ob[1]); wb.y = pk2(ob[2], ob[3]); wb.z = pk2(ob[4], ob[5]); wb.w = pk2(ob[6], ob[7]);
            __builtin_amdgcn_raw_buffer_store_b128(__builtin_bit_cast(__attribute__((__vector_size__(4 * sizeof(unsigned)))) unsigned, wa), rz_a, l0 * 2, 0, 0);
            __builtin_amdgcn_raw_buffer_store_b128(__builtin_bit_cast(__attribute__((__vector_size__(4 * sizeof(unsigned)))) unsigned, wb), rz_b, l0 * 2, 0, 0); }
        __syncthreads();
    }
}

constexpr int HN_RED = 104 * 1024, HN_RED2 = HN_RED + 16384, HN_RSTD = HN_RED2 + 2048;
__device__ __forceinline__ int hn_row(int c) { return (c + (c >> 5)) * 64; }
__device__ __forceinline__ void hyena_norm_phase(LAS unsigned char* lds, const bf16_t* pT, const float* out_g, bf16_t* mixo, int wg, int nwg, int tid) {
    LAS unsigned char* tile = lds; LAS float* red = (LAS float*)(lds + HN_RED); LAS float* red2 = (LAS float*)(lds + HN_RED2); LAS float* rstd = (LAS float*)(lds + HN_RSTD);
    const int lane = tid & 63, wave = tid >> 6, cl = tid >> 2, tg = tid & 3;
    const int pos = (nwg == 256) ? ((((wg >> 4) * 8 + (wg & 7)) << 1) | ((wg >> 3) & 1)) : wg;
    constexpr int NTILE = NT / 32;
    u32x4 v[12];
    float gv[12];
#pragma unroll
    for (int it = 0; it < 12; ++it) gv[it] = out_g[it * 128 + cl];
    int tt = pos;
    if (tt < NTILE) {
#pragma unroll
        for (int it = 0; it < 12; ++it) v[it] = *(const u32x4*)(pT + (size_t)(it * 128 + cl) * NT + tt * 32 + tg * 8); }
    for (; tt < NTILE; tt += nwg) {
        const int t0 = tt * 32;
        float ss[8] = {0.f, 0.f, 0.f, 0.f, 0.f, 0.f, 0.f, 0.f};
#pragma unroll
        for (int it = 0; it < 12; ++it) { const u32x4 q = v[it]; float f;
            f = bf_lo(q.x); ss[0] += f * f; f = bf_hi(q.x); ss[1] += f * f; f = bf_lo(q.y); ss[2] += f * f; f = bf_hi(q.y); ss[3] += f * f;
            f = bf_lo(q.z); ss[4] += f * f; f = bf_hi(q.z); ss[5] += f * f; f = bf_lo(q.w); ss[6] += f * f; f = bf_hi(q.w); ss[7] += f * f; }
        *(LAS f32x4*)(red + cl * 32 + tg * 8) = MK4(ss[0], ss[1], ss[2], ss[3]); *(LAS f32x4*)(red + cl * 32 + tg * 8 + 4) = MK4(ss[4], ss[5], ss[6], ss[7]);
        __syncthreads();
        { const int tk = tid & 31, part = tid >> 5; float s = 0.f;
#pragma unroll
          for (int r = 0; r < 8; ++r) s += red[(part * 8 + r) * 32 + tk];
          red2[part * 32 + tk] = s; }
        __syncthreads();
        if (tid < 32) { float s = 0.f;
#pragma unroll
            for (int p = 0; p < 16; ++p) s += red2[p * 32 + tid];
            rstd[tid] = 1.0f / sqrtf(s * (1.0f / HYW) + RMS_EPS); }
        __syncthreads();
        { const f32x4 r0 = *(const LAS f32x4*)(rstd + tg * 8), r1 = *(const LAS f32x4*)(rstd + tg * 8 + 4);
#pragma unroll
          for (int it = 0; it < 12; ++it) { const int c = it * 128 + cl; const float g = gv[it]; const u32x4 q = v[it]; u32x4 w;
              w.x = pk2(bf_lo(q.x) * r0[0] * g, bf_hi(q.x) * r0[1] * g); w.y = pk2(bf_lo(q.y) * r0[2] * g, bf_hi(q.y) * r0[3] * g);
              w.z = pk2(bf_lo(q.z) * r1[0] * g, bf_hi(q.z) * r1[1] * g); w.w = pk2(bf_lo(q.w) * r1[2] * g, bf_hi(q.w) * r1[3] * g);
              *(LAS u32x4*)(tile + hn_row(c) + ((tg ^ ((c >> 3) & 3)) << 4)) = w; } }
        __syncthreads();
        if (tt + nwg < NTILE) {
#pragma unroll
            for (int it = 0; it < 12; ++it) v[it] = *(const u32x4*)(pT + (size_t)(it * 128 + cl) * NT + (tt + nwg) * 32 + tg * 8); }
#pragma unroll
        for (int k = 0; k < 6; ++k) { const int combo = wave + 8 * k, tp = 4 * (combo & 3) + (lane & 3), cg = (combo >> 2) * 16 + (lane >> 2);
            unsigned d[8];
#pragma unroll
            for (int e = 0; e < 8; ++e) { const int c = 8 * cg + e; d[e] = *(const LAS unsigned*)(tile + hn_row(c) + ((((tp >> 2) ^ (cg & 3))) << 4) + (tp & 3) * 4); }
            u32x4 wl, wh;
            wl.x = (d[0] & 0xffffu) | (d[1] << 16); wl.y = (d[2] & 0xffffu) | (d[3] << 16); wl.z = (d[4] & 0xffffu) | (d[5] << 16); wl.w = (d[6] & 0xffffu) | (d[7] << 16);
            wh.x = (d[0] >> 16) | (d[1] & 0xffff0000u); wh.y = (d[2] >> 16) | (d[3] & 0xffff0000u); wh.z = (d[4] >> 16) | (d[5] & 0xffff0000u); wh.w = (d[6] >> 16) | (d[7] & 0xffff0000u);
            *(u32x4*)(mixo + (size_t)(t0 + 2 * tp) * D + 8 * cg) = wl; *(u32x4*)(mixo + (size_t)(t0 + 2 * tp + 1) * D + 8 * cg) = wh; }
    }
}

struct S5Args {
    const bf16_t* u5;
    const f32x2* lamb;
    const bf16_t* bua;
    const bf16_t* cmb;
    const float* dvec;
    f32x2* st;
    bf16_t* ssg;
};
__device__ __forceinline__ void s5_chunk_info(int cidx, int& c, int& nc, int& c0) {
    if (cidx < 256) { c = cidx & 63; nc = 64; c0 = cidx & ~63; } else { const int cc = cidx - 256; c = cc & 31; nc = 32; c0 = 256 + (cc & ~31); }
}
constexpr int S5_UP = 144;
constexpr int S5_UB = 0, S5_YB = 128 * S5_UP  , S5_SB = S5_YB + 65536  , S5_BB = S5_SB + 8 * 16 * 272  ;
template <int PASS>
__device__ __forceinline__ void s5_phase(LAS unsigned char* lds, const S5Args& A, int wg, int nwg, int tid) {
    LAS unsigned char* UB = lds + S5_UB; LAS float* yb = (LAS float*)(lds + S5_YB);
    const int lane = tid & 63, wave = __builtin_amdgcn_readfirstlane(tid >> 6), gl = wave & 3, dir = wave >> 2;
    LAS unsigned char* SBw = lds + S5_SB + wave * (16 * 272);
    LAS unsigned char* BBw = lds + S5_BB + wave * (16 * 256);
    const bool gbconst = (nwg & 7) == 0;
    const int n16 = lane & 15, kq = lane >> 4;
    f32x2 lam = MK2(0.f, 0.f); bf16x8 BfT[8], CfT[4];
    u32x4 pa[2];
#define S5_PREF(t_) do { const int gb_ = (t_) & 7, tt_ = ((t_) >> 3) * 128; _Pragma("unroll") for (int i = 0; i < 2; ++i) { const int id = tid + NWG_THREADS * i, row = id >> 3, c = id & 7; \
        pa[i] = *(const u32x4*)(A.u5 + (size_t)(tt_ + row) * 512 + gb_ * 64 + c * 8); } } while (0)
    if (wg < 320 * 8) S5_PREF(wg);
    for (int task = wg; task < 320 * 8; task += nwg) {
        const int gb = task & 7, cidx = task >> 3, t0 = cidx * 128, g = gb * 4 + gl, dg = dir * 32 + g;
        __syncthreads();
#pragma unroll
        for (int i = 0; i < 2; ++i) { const int id = tid + NWG_THREADS * i, row = id >> 3, c = id & 7; *(LAS u32x4*)(UB + row * S5_UP + c * 16) = pa[i]; }
        __syncthreads();
        if (task == wg || !gbconst) {
            lam = A.lamb[dg * 64 + lane];
#pragma unroll
            for (int ti = 0; ti < 8; ++ti) BfT[ti] = *(const bf16x8*)(A.bua + ((size_t)(dg * 8 + ti) * 64 + lane) * 8);
            if (PASS == 1) {
#pragma unroll
                for (int s = 0; s < 4; ++s) CfT[s] = *(const bf16x8*)(A.cmb + ((size_t)(dg * 4 + s) * 64 + lane) * 8); }
        }
        float sr = 0.f, si = 0.f;
        if (PASS == 1) {
            f32x2 lt = lam;
#pragma unroll
            for (int q = 0; q < 7; ++q) lt = MK2(lt.x * lt.x - lt.y * lt.y, 2.0f * lt.x * lt.y);
            int c, nc, c0; s5_chunk_info(cidx, c, nc, c0);
            const int nterm = dir ? (nc - 1 - c) : c;
            for (int j0 = 0; j0 < nterm; j0 += 16) { f32x2 e[16];
#pragma unroll
                for (int k = 0; k < 16; ++k) { const int j = j0 + k; const int cj = dir ? (nc - 1 - j) : j;
                    e[k] = (j < nterm) ? A.st[((size_t)(c0 + cj) * 2 + dir) * 2048 + g * 64 + lane] : MK2(0.f, 0.f); }
#pragma unroll
                for (int k = 0; k < 16; ++k) if (j0 + k < nterm) { const float nr = lt.x * sr - lt.y * si + e[k].x, ni = lt.x * si + lt.y * sr + e[k].y; sr = nr; si = ni; } }
        }
        if (task + nwg < 320 * 8) S5_PREF(task + nwg);
#pragma unroll 1
        for (int blk = 0; blk < 8; ++blk) {
            { const int tb = dir ? (127 - (16 * blk + n16)) : (16 * blk + n16);
              u32x4 ub = (u32x4){0u, 0u, 0u, 0u};
              if (kq < 2) ub = *(const LAS u32x4*)(UB + tb * S5_UP + gl * 32 + kq * 16);
              const bf16x8 Uf = __builtin_bit_cast(bf16x8, ub);
              f32x4 zz[8];
#pragma unroll
              for (int ti = 0; ti < 8; ++ti) {
                  zz[ti] = __builtin_amdgcn_mfma_f32_16x16x32_bf16(BfT[ti], Uf, (f32x4){0.f, 0.f, 0.f, 0.f}, 0, 0, 0); }
              asm volatile("s_nop 15" : "+v"(zz[0]), "+v"(zz[1]), "+v"(zz[2]), "+v"(zz[3]));
              asm volatile("s_nop 15" : "+v"(zz[4]), "+v"(zz[5]), "+v"(zz[6]), "+v"(zz[7]));
#pragma unroll
              for (int ti = 0; ti < 8; ++ti) { u32x2 w; w.x = pk2(zz[ti][0], zz[ti][1]); w.y = pk2(zz[ti][2], zz[ti][3]);
                  *(LAS u32x2*)(BBw + n16 * 256 + (8 * ti + 2 * kq) * 4) = w; }
              asm volatile("s_waitcnt lgkmcnt(0)" ::: "memory"); }
#pragma unroll
            for (int j = 0; j < 16; ++j) {
                const unsigned bw = *(const LAS unsigned*)(BBw + j * 256 + lane * 4);
                const float xr = bf_lo(bw), xi = bf_hi(bw);
                const float nr = lam.x * sr - lam.y * si + xr, ni = lam.x * si + lam.y * sr + xi; sr = nr; si = ni;
                if (PASS == 1) { *(LAS bf16_t*)(SBw + j * 272 + lane * 2) = (bf16_t)f2bf(sr); *(LAS bf16_t*)(SBw + j * 272 + 128 + lane * 2) = (bf16_t)f2bf(si); }
            }
            if (PASS == 1) {
                asm volatile("s_waitcnt lgkmcnt(0)" ::: "memory");
                f32x4 ya = (f32x4){0.f, 0.f, 0.f, 0.f};
#pragma unroll
                for (int s = 0; s < 4; ++s) { const bf16x8 Sf = *(const LAS bf16x8*)(SBw + n16 * 272 + 64 * s + 16 * kq);
                    ya = __builtin_amdgcn_mfma_f32_16x16x32_bf16(Sf, CfT[s], ya, 0, 0, 0); }
#pragma unroll
                for (int r = 0; r < 4; ++r) { const int tt = 16 * blk + 4 * kq + r, t = dir ? (127 - tt) : tt;
                    yb[(dir * 128 + t) * 64 + gl * 16 + n16] = ya[r]; }
            }
            asm volatile("s_waitcnt lgkmcnt(0)" ::: "memory");
        }
        if (PASS == 0) { A.st[((size_t)cidx * 2 + dir) * 2048 + g * 64 + lane] = MK2(sr, si); }
        else {
            __syncthreads();
#pragma unroll
            for (int i = 0; i < 16; ++i) { const int idx = tid + NWG_THREADS * i, t = idx >> 6, ch = idx & 63;
                const float u = bf1(*(const LAS bf16_t*)(UB + t * S5_UP + ch * 2));
                float y = yb[t * 64 + ch] + yb[(128 + t) * 64 + ch] + A.dvec[gb * 64 + ch] * u;
                const float z = 0.7978845608028654f * (y + 0.044715f * y * y * y);
                const float th = 1.0f - 2.0f / (1.0f + __expf(2.0f * z));
                y = 0.5f * y * (1.0f + th);
                A.ssg[(size_t)(t0 + t) * 512 + gb * 64 + ch] = (bf16_t)f2bf(y); }
        }
    }
#undef S5_PREF
}

__device__ __forceinline__ f32x4 mfma16(bf16x8 a, bf16x8 b, f32x4 c) { return __builtin_amdgcn_mfma_f32_16x16x32_bf16(a, b, c, 0, 0, 0); }
constexpr int RET_KP = 528, RET_VP = 136;
constexpr int RET_KB = 64 * RET_KP, RET_VB = 256 * RET_VP, RET_BUF = RET_KB + RET_VB;

__device__ __forceinline__ void ret_task(LAS unsigned char* lds, const bf16_t* p, const bf16_t* vT, bf16_t* mixo, const bf16_t* interf, const bf16_t* interb, const float* ret_decay, int seqtok0, int L, int h, int qb, int tid) {
    asm volatile("" : "+v"(tid));
    const int lane = tid & 63, w = __builtin_amdgcn_readfirstlane(tid >> 6), q = lane & 15, g = lane >> 4;
    const int qrow = qb * 128 + 16 * w + q;
    const float l2f = -expf(ret_decay[h]) * 1.4426950408889634f, l2b = -expf(ret_decay[4 + h]) * 1.4426950408889634f;
    bf16x8 Qf[8];
#pragma unroll
    for (int s = 0; s < 8; ++s) Qf[s] = *(const bf16x8*)(p + (size_t)(seqtok0 + qrow) * P_LD + h * 256 + 32 * s + 8 * g);
    f32x4 Oacc[16];
#pragma unroll
    for (int d = 0; d < 16; ++d) Oacc[d] = (f32x4){0.f, 0.f, 0.f, 0.f};
    constexpr int NKT = RC / 64; const int it0 = ((qb * 128) >> RCL) * NKT; (void)L;
    u32x4 kreg[4], vreg[4];
    const bf16_t* ksrc = p + (size_t)seqtok0 * P_LD + 1024 + h * 256;
    const bf16_t* vsrc = vT + (size_t)(h * 256) * NT + seqtok0;
#define RET_LOAD(it) do { _Pragma("unroll") for (int i = 0; i < 4; ++i) { const int id = tid + NWG_THREADS * i; \
        kreg[i] = *(const u32x4*)(ksrc + (size_t)(64 * (it) + (id >> 5)) * P_LD + 8 * (id & 31)); \
        vreg[i] = *(const u32x4*)(vsrc + (size_t)(id >> 3) * NT + 64 * (it) + 8 * (id & 7)); } } while (0)
#define RET_STORE(buf) do { LAS unsigned char* kb_ = lds + (buf) * RET_BUF; LAS unsigned char* vb_ = kb_ + RET_KB; _Pragma("unroll") for (int i = 0; i < 4; ++i) { const int id = tid + NWG_THREADS * i; \
        *(LAS u32x4*)(kb_ + (id >> 5) * RET_KP + 16 * (id & 31)) = kreg[i]; \
        *(LAS u32x2*)(vb_ + (id >> 3) * RET_VP + 16 * (id & 7)) = (u32x2){vreg[i].x, vreg[i].y}; *(LAS u32x2*)(vb_ + (id >> 3) * RET_VP + 16 * (id & 7) + 8) = (u32x2){vreg[i].z, vreg[i].w}; } } while (0)
    __syncthreads();
    RET_LOAD(it0); RET_STORE(0);
    __syncthreads();
    for (int it = it0; it < it0 + NKT; ++it) {
        if (it + 1 < it0 + NKT) RET_LOAD(it + 1);
        const LAS unsigned char* Kb = lds + ((it - it0) & 1) * RET_BUF; const LAS unsigned char* Vb = Kb + RET_KB;
        f32x4 P[4];
#pragma unroll
        for (int kb = 0; kb < 4; ++kb) {
            f32x4 st = (f32x4){0.f, 0.f, 0.f, 0.f};
#pragma unroll
            for (int s = 0; s < 8; ++s) { const bf16x8 Kf = *(const LAS bf16x8*)(Kb + (16 * kb + q) * RET_KP + 64 * s + 16 * g); st = mfma16(Kf, Qf[s], st); }
#pragma unroll
            for (int r = 0; r < 4; ++r) { const int dist = qrow - (64 * it + 16 * kb + 4 * g + r); const float fd = (float)dist;
                const float arg = dist >= 0 ? fd * l2f : -fd * l2b; st[r] *= __builtin_amdgcn_exp2f(arg); }
            P[kb] = st;
            __builtin_amdgcn_sched_barrier(0);
        }
#pragma unroll
        for (int kp = 0; kp < 2; ++kp) {
            u32x4 pw; pw.x = pk2(P[2 * kp][0], P[2 * kp][1]); pw.y = pk2(P[2 * kp][2], P[2 * kp][3]); pw.z = pk2(P[2 * kp + 1][0], P[2 * kp + 1][1]); pw.w = pk2(P[2 * kp + 1][2], P[2 * kp + 1][3]);
            const bf16x8 Pf = __builtin_bit_cast(bf16x8, pw);
#pragma unroll
            for (int db = 0; db < 16; ++db) { const LAS unsigned char* vp = Vb + (16 * db + q) * RET_VP + 64 * kp + 8 * g;
                const u32x2 lo = *(const LAS u32x2*)vp, hi = *(const LAS u32x2*)(vp + 32);
                const bf16x8 Vf = __builtin_bit_cast(bf16x8, (u32x4){lo.x, lo.y, hi.x, hi.y});
                Oacc[db] = mfma16(Vf, Pf, Oacc[db]);
                if ((db & 3) == 3) __builtin_amdgcn_sched_barrier(0); }
        }
        if (it + 1 < it0 + NKT) RET_STORE((it + 1 - it0) & 1);
        __syncthreads();
    }
#undef RET_LOAD
#undef RET_STORE
    { const size_t tk = (size_t)(seqtok0 + qrow);
#pragma unroll
      for (int d = 0; d < 16; ++d) { const u32x2 wf = *(const u32x2*)(interf + tk * 1024 + h * 256 + 16 * d + 4 * g), wb = *(const u32x2*)(interb + tk * 1024 + h * 256 + 16 * d + 4 * g);
          Oacc[d][0] += bf_lo(wf.x) + bf_lo(wb.x); Oacc[d][1] += bf_hi(wf.x) + bf_hi(wb.x); Oacc[d][2] += bf_lo(wf.y) + bf_lo(wb.y); Oacc[d][3] += bf_hi(wf.y) + bf_hi(wb.y); } }
    float s1 = 0.f;
#pragma unroll
    for (int d = 0; d < 16; ++d) s1 += (Oacc[d][0] + Oacc[d][1]) + (Oacc[d][2] + Oacc[d][3]);
    s1 += __shfl_xor(s1, 16); s1 += __shfl_xor(s1, 32);
    const float mu = s1 * (1.0f / 256.0f); float s2 = 0.f;
#pragma unroll
    for (int d = 0; d < 16; ++d)
#pragma unroll
        for (int r = 0; r < 4; ++r) { const float dd = Oacc[d][r] - mu; s2 += dd * dd; }
    s2 += __shfl_xor(s2, 16); s2 += __shfl_xor(s2, 32);
    const float rstd = 1.0f / sqrtf(s2 * (1.0f / 256.0f) + 1e-6f);
    const size_t tok = (size_t)(seqtok0 + qrow);
#pragma unroll
    for (int d = 0; d < 16; ++d) { const int dvc = 16 * d + 4 * g;
        const u32x2 gw = *(const u32x2*)(p + tok * P_LD + 2048 + h * 256 + dvc);
        const float gt[4] = {bf_lo(gw.x), bf_hi(gw.x), bf_lo(gw.y), bf_hi(gw.y)}; float o[4];
#pragma unroll
        for (int r = 0; r < 4; ++r) { const float sg = gt[r] / (1.0f + __expf(-gt[r])); o[r] = (Oacc[d][r] - mu) * rstd * sg; }
        u32x2 ow; ow.x = pk2(o[0], o[1]); ow.y = pk2(o[2], o[3]);
        *(u32x2*)(mixo + tok * D + h * 256 + dvc) = ow; }
}

__device__ __forceinline__ void na_wave_task(const bf16_t* p, const bf16_t* vT, bf16_t* mixo, const float* rpb, int seqtok0, int rows, int r, int h, int lane) {
    const int q = lane & 15, g = lane >> 4;
    int rs = r - 4; rs = rs < 0 ? 0 : (rs > rows - 8 ? rows - 8 : rs);
    const float* bias = rpb + (size_t)h * 15 * 31;
#pragma unroll 1
    for (int qb = 0; qb < 4; ++qb) {
        const int kc0 = (qb == 0) ? 0 : (qb == 1) ? 8 : (qb == 2) ? 24 : 32;
        const int c = 16 * qb + q; int cs = c - 8; cs = cs < 0 ? 0 : (cs > 48 ? 48 : cs);
        const size_t qtok = (size_t)seqtok0 + (size_t)r * 64 + c;
        bf16x8 Qf[2];
#pragma unroll
        for (int s = 0; s < 2; ++s) Qf[s] = *(const bf16x8*)(p + qtok * P_LD + 3072 + h * 64 + 32 * s + 8 * g);
        f32x4 Oacc[4];
#pragma unroll
        for (int d = 0; d < 4; ++d) Oacc[d] = (f32x4){0.f, 0.f, 0.f, 0.f};
        float mrun = -INFINITY, lrun = 0.f;
#pragma unroll 4
        for (int kr = 0; kr < 8; ++kr) {
            const size_t ktok0 = (size_t)seqtok0 + (size_t)(rs + kr) * 64 + kc0;
            const float* brow = bias + (rs + kr - r + 7) * 31;
            f32x4 S[2];
#pragma unroll
            for (int kb = 0; kb < 2; ++kb) { f32x4 st = (f32x4){0.f, 0.f, 0.f, 0.f};
#pragma unroll
                for (int s = 0; s < 2; ++s) { const bf16x8 Kf = *(const bf16x8*)(p + (ktok0 + 8 * (q >> 2) + 4 * kb + (q & 3)) * P_LD + 4096 + h * 64 + 32 * s + 8 * g); st = mfma16(Kf, Qf[s], st); }
                S[kb] = st; }
            float mx = -INFINITY;
#pragma unroll
            for (int kb = 0; kb < 2; ++kb)
#pragma unroll
                for (int rr = 0; rr < 4; ++rr) { const int kc = kc0 + 8 * g + 4 * kb + rr; const bool ok = (kc >= cs) && (kc < cs + 16);
                    const int co = kc - c + 15; float b = brow[co < 0 ? 0 : (co > 30 ? 30 : co)]; asm("" : "+v"(b));
                    const float v = ok ? S[kb][rr] + b : -INFINITY; S[kb][rr] = v; mx = fmaxf(mx, v); }
            mx = fmaxf(mx, __shfl_xor(mx, 16)); mx = fmaxf(mx, __shfl_xor(mx, 32));
            const float mnew = fmaxf(mrun, mx), alpha = __expf(mrun - mnew);
            float ps = 0.f;
#pragma unroll
            for (int kb = 0; kb < 2; ++kb)
#pragma unroll
                for (int rr = 0; rr < 4; ++rr) { const float e = __expf(S[kb][rr] - mnew); S[kb][rr] = e; ps += e; }
            ps += __shfl_xor(ps, 16); ps += __shfl_xor(ps, 32);
            lrun = lrun * alpha + ps; mrun = mnew;
            u32x4 pw; pw.x = pk2(S[0][0], S[0][1]); pw.y = pk2(S[0][2], S[0][3]); pw.z = pk2(S[1][0], S[1][1]); pw.w = pk2(S[1][2], S[1][3]);
            const bf16x8 Pf = __builtin_bit_cast(bf16x8, pw);
#pragma unroll
            for (int d = 0; d < 4; ++d) { const bf16x8 Vf = *(const bf16x8*)(vT + (size_t)(1024 + h * 64 + 16 * d + q) * NT + ktok0 + 8 * g);
                Oacc[d] = Oacc[d] * alpha; Oacc[d] = mfma16(Vf, Pf, Oacc[d]); }
        }
        const float inv = 1.0f / lrun;
#pragma unroll
        for (int d = 0; d < 4; ++d) { u32x2 ow; ow.x = pk2(Oacc[d][0] * inv, Oacc[d][1] * inv); ow.y = pk2(Oacc[d][2] * inv, Oacc[d][3] * inv);
            *(u32x2*)(mixo + qtok * D + 1024 + h * 64 + 16 * d + 4 * g) = ow; }
    }
}

__device__ __forceinline__ void ret_scan_phase(const bf16_t* UT, bf16_t* ST, const float* rd, int gtid, int NGT) {
    for (int w = gtid; w < 48 * 8192; w += NGT) {
        const int chain = w >> 13, e8 = w & 8191, dir = chain & 1, head = (chain >> 1) & 3, seq = chain >> 3;
        const int c0 = seq < 4 ? seq * (8192 / RC) : 4 * (8192 / RC) + (seq - 4) * (4096 / RC), nc = seq < 4 ? (8192 / RC) : (4096 / RC);
        const float gc = __builtin_amdgcn_exp2f(-expf(rd[dir * 4 + head]) * 1.4426950408889634f * (float)RC);
        float S[8];
#pragma unroll
        for (int e = 0; e < 8; ++e) S[e] = 0.f;
        for (int k = 0; k < nc; ++k) { const int c = dir ? (c0 + nc - 1 - k) : (c0 + k); const size_t off = (size_t)((c * 4 + head) * 2 + dir) * 65536 + (size_t)e8 * 8;
            *(u32x4*)(ST + off) = pack8(S);
            float U[8]; unpack8(*(const u32x4*)(UT + off), U);
#pragma unroll
            for (int e = 0; e < 8; ++e) S[e] = gc * S[e] + U[e]; }
    }
}

#ifndef ONE_LAUNCH
#define ONE_LAUNCH 1
#endif
#ifndef PROBE_MASK
#define PROBE_MASK 0
#endif
#define REPS(k) ((((PROBE_MASK) >> (k)) & 1) ? 2 : 1)
#define REP(k) for (int rep_ = 0; rep_ < REPS(k); ++rep_)
#ifndef PROBE_SUB
#define PROBE_SUB 0
#endif
#define REPSUB(n) for (int reps_ = 0; reps_ < ((((PROBE_SUB) >> (n)) & 1) ? 2 : 1); ++reps_)
#ifndef HOST_PROBE_K
#define HOST_PROBE_K 0
#endif
#ifndef HOST_PROBE_SUB
#define HOST_PROBE_SUB 0
#endif
#ifndef PROBE_HYN
#define PROBE_HYN 1
#endif
#ifndef STOP_PHASE
#define STOP_PHASE 65
#endif
enum { I_XP = 0, I_XS, I_MEMP, I_MEMS, I_NORMG, I_MIXWO, I_EVWIN, I_HYSW, I_HYSB, I_HYW1, I_HYB1, I_HYFREQ, I_HYW2, I_HYB2, I_HYW3, I_HYSKIP, I_HYOUTG,
       I_S5ARE, I_S5AIM, I_S5LOGDT, I_S5BRE, I_S5BIM, I_S5CRE, I_S5CIM, I_S5D, I_S5WGLU, I_ODWIN, I_RETDECAY, I_NARPB, I_MEMNORMG, I_XAWQ, I_XAWKV, I_XAWO, I_FFNWG, I_FFNWU, I_FFNWD, N_INPUTS };
struct Args { const float* in[N_INPUTS]; float* out; unsigned char* ws; int ph_lo, ph_hi; };

constexpr int LDS_PTRTAB = LDS_BYTES - 1024;
__device__ __forceinline__ const float* inptr(LAS unsigned char* lds, int i) {
    const unsigned long long v = ((const LAS unsigned long long*)(lds + LDS_PTRTAB))[i];
    const unsigned lo = __builtin_amdgcn_readfirstlane((unsigned)v), hi = __builtin_amdgcn_readfirstlane((unsigned)(v >> 32));
    return (const float*)(const GAS float*)(((unsigned long long)hi << 32) | lo);
}
#define RUN(id) ((KSEL < 0 || KSEL == ((id) & 15) || (KSEL == 15 && (id) == 64)) && args.ph_lo <= (id) && (id) < args.ph_hi)
#define SEAM() do { if (one) { unsigned long long bi_ = (unsigned long long)args.ws; asm volatile("" : "+s"(bi_)); XcdBarrier b_; b_.bar = (unsigned*)(GAS unsigned*)bi_ + CW_BAR; b_.x = xb_xcc_id(); b_.st = MISC + 8; xcd_barrier(b_, wave_s == 0 && __builtin_amdgcn_mbcnt_hi(~0u, __builtin_amdgcn_mbcnt_lo(~0u, 0u)) == 0u); } } while (0)
#define SUBRUN(n) (SUB < 0 || SUB == (n))
#define PH_BEGIN() unsigned long long wsi_ = (unsigned long long)args.ws, outi_ = (unsigned long long)args.out; int tid = wave_s * 64 + (int)__builtin_amdgcn_mbcnt_hi(~0u, __builtin_amdgcn_mbcnt_lo(~0u, 0u)), wg = blockIdx.x, nwg = gridDim.x; \
    asm volatile("" : "+s"(wsi_), "+s"(outi_), "+v"(tid), "+s"(wg), "+s"(nwg)); \
    unsigned char* const ws = (unsigned char*)(GAS unsigned char*)wsi_; float* const x = (float*)(GAS float*)outi_; unsigned char* const big = ws + WS_BIG; (void)x; (void)big; \
    const int lane = tid & 63, wave = __builtin_amdgcn_readfirstlane(tid >> 6), gw = wg * 8 + wave, NGW = nwg * 8, gtid = wg * NWG_THREADS + tid, NGT = nwg * NWG_THREADS; (void)lane; (void)gw; (void)NGW; (void)gtid; (void)NGT;
#define IN(i) inptr(lds, (i))
#define WP(off) ((bf16_t*)(ws + WS_W + (off)))
#define HBUF ((bf16_t*)(ws + WS_H))
#define XBUF ((bf16_t*)(ws + WS_X))
#define MIXO ((bf16_t*)(ws + WS_MIXO))
#define TMPB ((bf16_t*)(ws + WS_TMP))
#define MEMN ((bf16_t*)(ws + WS_MEMN))
#define KMEM ((bf16_t*)(ws + WS_KMEM))
#define VTM ((bf16_t*)(ws + WS_VT))

template <int KSEL, int SUB, int LAYER> __device__ __forceinline__ void layer_body(const Args& args, LAS unsigned char* lds, volatile LAS unsigned* MISC, const bool one, const int wave_s) {
    constexpr int layer = LAYER;
        const int pb = layer * 16, li = layer >> 1; const bool even = (layer & 1) == 0;
        if (RUN(pb + 0)) { PH_BEGIN();
            const float* ng = IN(I_NORMG) + (size_t)layer * 6 * D;
            if (layer == 0) nrn_phase<0>(IN(I_XP), IN(I_XS), XBUF, x, TMPB, ng, ng, HBUF, gw, NGW, lane);
            else nrn_phase<1>(nullptr, nullptr, XBUF, x, TMPB, ng - D, ng, HBUF, gw, NGW, lane);
            for (int rep_ = 0; rep_ < REPS(0); ++rep_) {
            LAS float* scr = (LAS float*)(lds + wave * 16384);
            if (even) { wt_matrix(IN(I_EVWIN) + (size_t)li * D * 5120, D, 5120, WP(W_IN), MapId{0}, scr, gw, NGW, lane);
                        wt_matrix(IN(I_S5WGLU) + (size_t)li * 512 * 512, 512, 512, WP(W_GLU), MapId{0}, scr, gw, NGW, lane); }
            else wt_matrix(IN(I_ODWIN) + (size_t)li * D * 7168, D, 7168, WP(W_IN), MapOdd{}, scr, gw, NGW, lane);
            wt_matrix(IN(I_MIXWO) + (size_t)layer * D * D, D, D, WP(W_O), MapId{0}, scr, gw, NGW, lane);
            wt_matrix(IN(I_XAWQ) + (size_t)layer * D * D, D, D, WP(W_Q), MapId{0}, scr, gw, NGW, lane);
            wt_matrix(IN(I_XAWKV) + (size_t)layer * D * 2 * D, D, 2 * D, WP(W_KV), MapId{0}, scr, gw, NGW, lane);
            wt_matrix(IN(I_XAWO) + (size_t)layer * D * D, D, D, WP(W_XO), MapId{0}, scr, gw, NGW, lane);
            wt_matrix(IN(I_FFNWG) + (size_t)layer * D * FFN, D, FFN, WP(W_GU), MapGU{0}, scr, gw, NGW, lane);
            wt_matrix(IN(I_FFNWU) + (size_t)layer * D * FFN, D, FFN, WP(W_GU), MapGU{1}, scr, gw, NGW, lane);
            wt_matrix(IN(I_FFNWD) + (size_t)layer * FFN * D, FFN, D, WP(W_D), MapId{0}, scr, gw, NGW, lane);
            memnorm_phase(IN(I_MEMP), IN(I_MEMS), IN(I_MEMNORMG) + (size_t)layer * D, MEMN, gw, NGW, lane);
            if (!even && gtid < 8) ((float*)(ws + WS_L2G))[gtid] = -expf(IN(I_RETDECAY)[li * 8 + gtid]) * 1.4426950408889634f;
            if (layer == 0) tables_phase((f32x2*)(ws + WS_TW), (float*)(ws + WS_ROTC), (float*)(ws + WS_ROTS), gtid, NGT);
            if (even) {
                hyena_hid_phase(IN(I_HYW1) + (size_t)li * 33 * 64, IN(I_HYB1) + li * 64, IN(I_HYFREQ) + li * 128, IN(I_HYW2) + (size_t)li * 4096, IN(I_HYB2) + li * 64, (bf16_t*)(ws + WS_HID2), gw, NGW, lane);
                s5_tables_phase(IN(I_S5ARE) + li * 4096, IN(I_S5AIM) + li * 4096, IN(I_S5LOGDT) + li * 64, IN(I_S5BRE) + (size_t)li * 65536, IN(I_S5BIM) + (size_t)li * 65536, IN(I_S5CRE) + (size_t)li * 65536, IN(I_S5CIM) + (size_t)li * 65536,
                                (f32x2*)(ws + WS_S5T), (bf16_t*)(ws + WS_S5T + 32768), (bf16_t*)(ws + WS_S5T + 32768 + 524288), gtid, NGT);
            }
            }
            SEAM();
        }
        if (RUN(pb + 1)) { REP(1) {
            if (even) {
                { PH_BEGIN(); pg8::StdSched S; S.init(WP(W_IN), D, 4608, HBUF, D, NT, nwg, wg); pg8::EpiBf16 E{(bf16_t*)(big + BIG_PT), NT, 0}; pg8::gemm_phase(lds, tid, D, D, D, S, E); }
                { PH_BEGIN(); pg8::StdSched S; S.init(HBUF, D, NT, WP(W_IN) + (size_t)4608 * D, D, 512, nwg, (wg + 64) % nwg); pg8::EpiBf16 E{(bf16_t*)(big + BIG_U5), 512, 0}; pg8::gemm_phase(lds, tid, D, D, D, S, E); }
            } else {
                { PH_BEGIN(); pg8::StdSched S; S.init(HBUF, D, NT, WP(W_IN), D, 5120, nwg, wg); pg8::EpiRot E{(bf16_t*)(big + BIG_P), P_LD, (const float*)(ws + WS_ROTC), (const float*)(ws + WS_ROTS), TMPB, (const float*)(ws + WS_L2G)}; pg8::gemm_phase(lds, tid, D, D, D, S, E); }
                { PH_BEGIN(); pg8::StdSched S; S.init(WP(W_IN) + (size_t)5120 * D, D, 2048, HBUF, D, NT, nwg, wg); pg8::EpiBf16 E{(bf16_t*)(big + BIG_VT), NT, 0}; pg8::gemm_phase(lds, tid, D, D, D, S, E); }
            }
            { PH_BEGIN(); pg8::StdSched S; S.init(MEMN, D, NMEMTOK, WP(W_KV), D, 2048, nwg, (wg + (even ? 192 : 64)) % nwg); pg8::EpiBf16 E{KMEM, D, 0}; pg8::gemm_phase(lds, tid, D, D, D, S, E); }
            { PH_BEGIN(); pg8::StdSched S; S.init(WP(W_KV) + (size_t)2048 * D, D, 2048, MEMN, D, NMEMTOK, nwg, (wg + (even ? 144 : 112)) % nwg); pg8::EpiBf16 E{VTM, NMEMTOK, 0}; pg8::gemm_phase(lds, tid, D, D, D, S, E); }
            }
            SEAM();
        }
        if (RUN(pb + 2)) { REP(2) {
            if (even) {
#define HY_ARGS() HyArgs H; H.pT = (const bf16_t*)(big + BIG_PT); H.short_w = IN(I_HYSW) + (size_t)li * 3 * 4608; H.short_b = IN(I_HYSB) + (size_t)li * 4608; H.hid2 = (const bf16_t*)(ws + WS_HID2); \
                H.w3 = IN(I_HYW3) + (size_t)li * 64 * 6144; H.skip = IN(I_HYSKIP) + (size_t)li * 2 * HYW; H.TW = (const f32x2*)(ws + WS_TW); H.z2 = HBUF; \
                f32x4* spec = (f32x4*)(ws + WS_HYSCR + (size_t)wg * HYSCR_PER_WG);
                if (SUBRUN(0)) REPSUB(0) { PH_BEGIN(); HY_ARGS(); for (int cp = wg; cp < 768; cp += nwg) hyena_task<14>(lds, H, 2 * cp, 0, 4, spec, tid); }
                if (SUBRUN(1)) REPSUB(1) { PH_BEGIN(); HY_ARGS(); for (int cp = wg; cp < 768; cp += nwg) hyena_task<13>(lds, H, 2 * cp, NPROMPT, 2, spec, tid); }
#undef HY_ARGS
                if (SUBRUN(2)) REPSUB(2) { PH_BEGIN(); S5Args A; A.u5 = (const bf16_t*)(big + BIG_U5); A.lamb = (const f32x2*)(ws + WS_S5T); A.bua = (const bf16_t*)(ws + WS_S5T + 32768);
                    A.cmb = (const bf16_t*)(ws + WS_S5T + 32768 + 524288); A.dvec = IN(I_S5D) + li * 512; A.st = (f32x2*)(ws + WS_S5ST); A.ssg = (bf16_t*)(big + BIG_SSG);
                    s5_phase<0>(lds, A, wg, nwg, tid); }
            } else {
                if (SUBRUN(3)) REPSUB(3) { PH_BEGIN();
                    pg8::RetUSched S{(const char*)(big + BIG_VT), (const char*)TMPB, (const char*)(TMPB + (size_t)1024 * NT), nwg, wg}; pg8::EpiBf16 E{MIXO, 256, 0}; pg8::gemm_phase(lds, tid, RC, NT, NT, S, E); }
            }
            }
            SEAM();
        }
        if (RUN(pb + 3) && !even) {
            if (SUBRUN(0)) { PH_BEGIN(); ret_scan_phase(MIXO, MIXO + (size_t)RUNITS * 65536, IN(I_RETDECAY) + li * 8, gtid, NGT); }
            SEAM();
            if (SUBRUN(1)) { PH_BEGIN(); LAS unsigned long long* slots = (LAS unsigned long long*)(lds + LDS_PTRTAB + 320);
                if (tid == 0) { slots[0] = (unsigned long long)(big + BIG_P); slots[1] = (unsigned long long)(MIXO + (size_t)RUNITS * 65536); }
                __syncthreads();
                pg8::RetISched S{slots, nwg, wg};
                pg8::EpiInter E{HBUF, (const float*)(ws + WS_L2G)}; pg8::gemm_phase(lds, tid, 256, P_LD, 256, S, E); }
            SEAM();
        }
        if (RUN(pb + 3) && even) { REP(3) {
            { PH_BEGIN(); S5Args A; A.u5 = (const bf16_t*)(big + BIG_U5); A.lamb = (const f32x2*)(ws + WS_S5T); A.bua = (const bf16_t*)(ws + WS_S5T + 32768);
              A.cmb = (const bf16_t*)(ws + WS_S5T + 32768 + 524288); A.dvec = IN(I_S5D) + li * 512; A.st = (f32x2*)(ws + WS_S5ST); A.ssg = (bf16_t*)(big + BIG_SSG);
              s5_phase<1>(lds, A, wg, nwg, tid); }
            __syncthreads();
            for (int rh_ = 0; rh_ < PROBE_HYN; ++rh_) { PH_BEGIN(); hyena_norm_phase(lds, HBUF, IN(I_HYOUTG) + (size_t)li * HYW, MIXO, wg, nwg, tid); __syncthreads(); }
            __syncthreads(); }
            SEAM();
        }
        if (RUN(pb + 4) && !even) {
            if (SUBRUN(0)) { PH_BEGIN(); const bf16_t* p = (const bf16_t*)(big + BIG_P); const bf16_t* vT = (const bf16_t*)(big + BIG_VT); const float* rd = IN(I_RETDECAY) + li * 8;
                const int wgp = (nwg == 256) ? ((wg & ~31) | ((wg & 7) << 2) | ((wg >> 3) & 3)) : wg;
                for (int id = wgp; id < 1280; id += nwg) { const bool pr = id < 1024; const int j = id - 1024;
                    ret_task(lds, p, vT, MIXO, HBUF, HBUF + (size_t)NT * 1024, rd, pr ? (id >> 8) * 8192 : NPROMPT + (j >> 7) * 4096, pr ? 8192 : 4096, pr ? (id >> 6) & 3 : (j >> 5) & 3, pr ? id & 63 : j & 31, tid); } }
            if (SUBRUN(1)) { PH_BEGIN(); const bf16_t* p = (const bf16_t*)(big + BIG_P); const bf16_t* vT = (const bf16_t*)(big + BIG_VT); const float* rpb = IN(I_NARPB) + (size_t)li * 16 * 15 * 31;
                for (int k = 0; k < (640 * 16 + NGW - 1) / NGW; ++k) { int id = gw + NGW * k;
                    if (nwg == 256) { const int lw = (wg >> 3) * 8 + wave; id = ((80 * (wg & 7) + 16 * k + (lw >> 4)) << 4) | (lw & 15); }
                    if (id >= 640 * 16) continue;
                    const int h = id & 15, rowid = id >> 4;
                    if (rowid < 512) na_wave_task(p, vT, MIXO, rpb, (rowid >> 7) * 8192, 128, rowid & 127, h, lane);
                    else { const int rr = rowid - 512; na_wave_task(p, vT, MIXO, rpb, NPROMPT + (rr >> 6) * 4096, 64, rr & 63, h, lane); } } }
            SEAM();
        }
        if (RUN(pb + 4) && even) { REP(4) { PH_BEGIN();
            pg8::StdSched S; S.init((const bf16_t*)(big + BIG_SSG), 512, NT, WP(W_GLU), 512, 512, nwg, wg);
            pg8::EpiGLU E{(const bf16_t*)(big + BIG_SSG), MIXO, 512, D, HYW}; asm volatile("" : "+v"(tid)); pg8::gemm_phase(lds, tid, 512, 512, 512, S, E); }
            SEAM();
        }
        if (RUN(pb + 5)) { REP(5) { PH_BEGIN(); pg8::StdSched S; S.init(MIXO, D, NT, WP(W_O), D, D, nwg, wg); pg8::EpiBf16 E{TMPB, D, 0}; asm volatile("" : "+v"(tid)); pg8::gemm_phase(lds, tid, D, D, D, S, E); } SEAM(); }
        if (RUN(pb + 6)) { PH_BEGIN(); const float* ng = IN(I_NORMG) + (size_t)layer * 6 * D; nrn_phase<1>(nullptr, nullptr, XBUF, x, TMPB, ng + D, ng + 2 * D, HBUF, gw, NGW, lane); SEAM(); }
        if (RUN(pb + 7)) { REP(7) { PH_BEGIN(); pg8::StdSched S; S.init(HBUF, D, NT, WP(W_Q), D, D, nwg, wg); pg8::EpiBf16 E{(bf16_t*)(big + BIG_Q), D, 0}; asm volatile("" : "+v"(tid)); pg8::gemm_phase(lds, tid, D, D, D, S, E); } SEAM(); }
        if (RUN(pb + 8)) { REP(8) { PH_BEGIN(); pg8::QKSched S{(const char*)(big + BIG_Q), (const char*)KMEM, nwg, wg}; pg8::EpiF32 E{(float*)(big + BIG_S), 1024, 256, 0.044194173824159216f}; asm volatile("" : "+v"(tid)); pg8::gemm_phase(lds, tid, 512, D, D, S, E); } SEAM(); }
        if (RUN(pb + 9)) { REP(9) { PH_BEGIN(); softmax_phase((const float*)(big + BIG_S), (bf16_t*)(big + BIG_PB), gw, NGW, lane); } SEAM(); }
        if (RUN(pb + 10)) { REP(10) { PH_BEGIN(); pg8::PVSched S{(const char*)(big + BIG_PB), (const char*)VTM, nwg, wg}; pg8::EpiBf16 E{(bf16_t*)(big + BIG_O), D, 512}; asm volatile("" : "+v"(tid)); pg8::gemm_phase(lds, tid, 256, 1024, NMEMTOK, S, E); } SEAM(); }
        if (RUN(pb + 11)) { REP(11) { PH_BEGIN(); pg8::StdSched S; S.init((const bf16_t*)(big + BIG_O), D, NT, WP(W_XO), D, D, nwg, wg); pg8::EpiBf16 E{TMPB, D, 0}; asm volatile("" : "+v"(tid)); pg8::gemm_phase(lds, tid, D, D, D, S, E); } SEAM(); }
        if (RUN(pb + 12)) { PH_BEGIN(); const float* ng = IN(I_NORMG) + (size_t)layer * 6 * D; nrn_phase<1>(nullptr, nullptr, XBUF, x, TMPB, ng + 3 * D, ng + 4 * D, HBUF, gw, NGW, lane); SEAM(); }
        if (RUN(pb + 13)) { REP(13) { PH_BEGIN(); pg8::StdSched S; S.init(HBUF, D, NT, WP(W_GU), D, 2 * FFN, nwg, wg); pg8::EpiSwiGLU E{(bf16_t*)(big + BIG_HID), FFN}; asm volatile("" : "+v"(tid)); pg8::gemm_phase(lds, tid, D, D, D, S, E); } SEAM(); }
        if (RUN(pb + 14)) { REP(14) { PH_BEGIN(); pg8::StdSched S; S.init((const bf16_t*)(big + BIG_HID), FFN, NT, WP(W_D), FFN, D, nwg, wg); pg8::EpiBf16 E{TMPB, D, 0}; asm volatile("" : "+v"(tid)); pg8::gemm_phase(lds, tid, FFN, FFN, FFN, S, E); } SEAM(); }
    }

template <int KSEL, int SUB> __device__ __forceinline__ void trunk_body(const Args& args) {
    extern __shared__ __attribute__((aligned(16))) unsigned char lds_raw[];
    LAS unsigned char* lds = (LAS unsigned char*)lds_raw;
    const bool one = (args.ph_hi - args.ph_lo) > 1;
    volatile LAS unsigned* MISC = (volatile LAS unsigned*)(lds + LDS_MISC);
    if (threadIdx.x < 64) MISC[threadIdx.x] = 0u;
    if (threadIdx.x == 0) {
#pragma unroll
        for (int i = 0; i < N_INPUTS; ++i) ((LAS unsigned long long*)(lds + LDS_PTRTAB))[i] = (unsigned long long)args.in[i];
    }
    __syncthreads();
    const int wave_s = __builtin_amdgcn_readfirstlane((int)threadIdx.x >> 6);
    if (one) (void)xcd_barrier_post((unsigned*)args.ws + CW_BAR, MISC + 8, threadIdx.x == 0);
    layer_body<KSEL, SUB, 0>(args, lds, MISC, one, wave_s);
    layer_body<KSEL, SUB, 1>(args, lds, MISC, one, wave_s);
    layer_body<KSEL, SUB, 2>(args, lds, MISC, one, wave_s);
    layer_body<KSEL, SUB, 3>(args, lds, MISC, one, wave_s);
    if (RUN(64)) { PH_BEGIN(); const float* ng = IN(I_NORMG) + (size_t)3 * 6 * D; nrn_phase<2>(nullptr, nullptr, XBUF, x, TMPB, ng + 5 * D, ng, HBUF, gw, NGW, lane); }
#undef RUN
#undef SEAM
}

template <int KSEL, int SUB> __global__ void __launch_bounds__(NWG_THREADS, 2) trunk_k(Args args) { trunk_body<KSEL, SUB>(args); }

static bool phase_nonempty(int id) {
    if (id == 64) return true;
    const int layer = id >> 4, k = id & 15; if (layer >= DEPTH || k > 14) return false;
    return true;
}
typedef void (*kern_t)(Args);
static kern_t kern_of(int k, int sub) {
    switch (k) {
#if ONE_LAUNCH
        default: return trunk_k<-1, -1>;
#else
        case 0: return trunk_k<0, -1>; case 1: return trunk_k<1, -1>;
        case 3: switch (sub) { case 0: return trunk_k<3, 0>; case 1: return trunk_k<3, 1>; default: return trunk_k<3, -1>; }
        case 4: switch (sub) { case 0: return trunk_k<4, 0>; case 1: return trunk_k<4, 1>; default: return trunk_k<4, -1>; } case 5: return trunk_k<5, -1>; case 6: return trunk_k<6, -1>; case 7: return trunk_k<7, -1>;
        case 8: return trunk_k<8, -1>; case 9: return trunk_k<9, -1>; case 10: return trunk_k<10, -1>; case 11: return trunk_k<11, -1>; case 12: return trunk_k<12, -1>; case 13: return trunk_k<13, -1>; case 14: return trunk_k<14, -1>;
        case 2: switch (sub) { case 0: return trunk_k<2, 0>; case 1: return trunk_k<2, 1>; case 2: return trunk_k<2, 2>; case 3: return trunk_k<2, 3>; default: return trunk_k<2, 4>; }
        default: return trunk_k<15, -1>;
#endif
    }
}
extern "C" void kernel_launch(void* const* d_in, const int* in_sizes, int n_in, void* d_out, int out_size, void* d_ws, size_t ws_size, hipStream_t stream) {
    static int grid = 0;
    if (grid == 0) {
        if (n_in != N_INPUTS || out_size != NT * D || ws_size < WS_END) { fprintf(stderr, "kernel_launch: unexpected problem (n_in %d out %d ws %zu, need %zu)\n", n_in, out_size, ws_size, (size_t)WS_END); grid = -1; return; }
        int dev = 0, cus = 0;
        if (hipGetDevice(&dev) != hipSuccess || hipDeviceGetAttribute(&cus, hipDeviceAttributeMultiprocessorCount, dev) != hipSuccess) { grid = -1; return; }
        for (int k = 0; k < 16 * 5; ++k) if (hipFuncSetAttribute((const void*)kern_of(k / 5, k % 5), hipFuncAttributeMaxDynamicSharedMemorySize, LDS_BYTES) != hipSuccess) { fprintf(stderr, "kernel_launch: hipFuncSetAttribute failed\n"); grid = -1; return; }
        (void)hipGetLastError();
        grid = cus < 256 ? cus : 256;
    }
    if (grid < 0) return;
    (void)hipMemsetAsync((char*)d_ws + WS_CTL, 0, 1 * MiB, stream);
    Args a{};
    for (int i = 0; i < N_INPUTS; ++i) a.in[i] = (const float*)d_in[i];
    a.out = (float*)d_out; a.ws = (unsigned char*)d_ws;
#if ONE_LAUNCH
    a.ph_lo = 0; a.ph_hi = STOP_PHASE;
    hipLaunchKernelGGL(kern_of(0, 0), dim3(grid), dim3(NWG_THREADS), LDS_BYTES, stream, a);
#else
    for (int id = 0; id < STOP_PHASE; ++id) { if (!phase_nonempty(id)) continue; a.ph_lo = id; a.ph_hi = id + 1;
        const int k = id == 64 ? 15 : (id & 15); const bool odd = (id >> 4) & 1;
        if (odd && (k == 3 || k == 4)) { hipLaunchKernelGGL(kern_of(k, 0), dim3(grid), dim3(NWG_THREADS), LDS_BYTES, stream, a); hipLaunchKernelGGL(kern_of(k, 1), dim3(grid), dim3(NWG_THREADS), LDS_BYTES, stream, a); }
        else if (k == 2) { for (int sub = odd ? 3 : 0; sub < (odd ? 4 : 3); ++sub) for (int r = 0; r < ((((HOST_PROBE_SUB) >> sub) & 1) ? 2 : 1); ++r) hipLaunchKernelGGL(kern_of(2, sub), dim3(grid), dim3(NWG_THREADS), LDS_BYTES, stream, a); }
        else for (int r = 0; r < ((((HOST_PROBE_K) >> k) & 1) ? 2 : 1); ++r) hipLaunchKernelGGL(kern_of(k, 2), dim3(grid), dim3(NWG_THREADS), LDS_BYTES, stream, a); }
#endif
}
```
